# Optimizing an MI355X kernel written in HIP

```python
import jax, jax.numpy as jnp
from jax import lax
import numpy as np

D_MODEL = 1024
BATCH = 8
SEQ = 8192
DEPTH = 2
DEC_BATCH = 8
DEC_SEQ = 64
PAST_LEN = 4096

CHUNK = 64
PLE_DIM = 256
EPS = 1e-6
NEG_INF = -1e30
Q_BLOCK = 128
MLA_HEADS = 8
MLA_NOPE = 64
MLA_ROPE = 32
MLA_V = 64
MLA_Q_RANK = 256
MLA_KV_RANK = 128
MLA_WIDTH = MLA_HEADS * MLA_V
ROPE_THETA = 10000.0
POOL_WINDOWS = (2, 4, 8, 16)
POOL_GROUP_DIM = 64
POOL_WIDTH = 4 * POOL_GROUP_DIM
POOL_HIST = 15
CA_HEADS = 4
CA_HEAD_DIM = 64
CA_WIDTH = CA_HEADS * CA_HEAD_DIM
CA_LEFT_CHUNKS = 8
CA_WINDOW = CA_LEFT_CHUNKS * CHUNK
CA_MAX_REL = 128
N_BRANCH = 3
IN_SIZES = (MLA_Q_RANK, MLA_KV_RANK + MLA_ROPE, MLA_WIDTH, POOL_WIDTH, POOL_WIDTH, 3 * CA_WIDTH, CA_WIDTH, N_BRANCH * D_MODEL)
IN_TOTAL = MLA_Q_RANK + MLA_KV_RANK + MLA_ROPE + MLA_WIDTH + 2 * POOL_WIDTH + 4 * CA_WIDTH + N_BRANCH * D_MODEL

kernel_name = "hybrid_stream_mla_pool_chunkattn_step"


def rmsnorm(x, g):
    xf = x.astype(jnp.float32)
    y = xf * lax.rsqrt(jnp.mean(xf * xf, axis=-1, keepdims=True) + EPS)
    return (y * g.astype(jnp.float32)).astype(x.dtype)


def rope(x, pos):
    half = x.shape[-1] // 2
    inv = ROPE_THETA ** (-jnp.arange(half, dtype=jnp.float32) / half)
    ang = pos.astype(jnp.float32)[:, None] * inv[None, :]
    ang = ang.reshape((ang.shape[0],) + (1,) * (x.ndim - 3) + (half,))
    cos, sin = jnp.cos(ang), jnp.sin(ang)
    xf = x.astype(jnp.float32)
    x1, x2 = xf[..., :half], xf[..., half:]
    return jnp.concatenate([x1 * cos - x2 * sin, x1 * sin + x2 * cos], axis=-1).astype(x.dtype)


def split_cols(z):
    outs, off = [], 0
    for n in IN_SIZES:
        outs.append(z[..., off:off + n])
        off += n
    return outs


def mla_attend(q_nope, q_rope, q_pos, ckv_all, krope_all, k_pos, w_ukv, kn_nope):
    B, Lq = q_nope.shape[:2]
    Lk = ckv_all.shape[1]
    kv = (ckv_all @ w_ukv).reshape(B, Lk, MLA_HEADS, MLA_NOPE + MLA_V)
    k_nope = rmsnorm(kv[..., :MLA_NOPE], kn_nope)
    v = kv[..., MLA_NOPE:]
    k_chunk = k_pos // CHUNK
    scale = (MLA_NOPE + MLA_ROPE) ** -0.5

    def block(args):
        qn, qr, qp = args
        s = jnp.einsum("bqhd,bkhd->bhqk", qn, k_nope) + jnp.einsum("bqhr,bkr->bhqk", qr, krope_all)
        s = s.astype(jnp.float32) * scale
        mask = k_chunk[None, :] <= (qp // CHUNK)[:, None]
        s = jnp.where(mask[None, None], s, NEG_INF)
        pr = jax.nn.softmax(s, axis=-1).astype(v.dtype)
        return jnp.einsum("bhqk,bkhd->bqhd", pr, v)

    if Lq > Q_BLOCK and Lq % Q_BLOCK == 0:
        nb = Lq // Q_BLOCK
        qn_b = q_nope.reshape(B, nb, Q_BLOCK, MLA_HEADS, MLA_NOPE).swapaxes(0, 1)
        qr_b = q_rope.reshape(B, nb, Q_BLOCK, MLA_HEADS, MLA_ROPE).swapaxes(0, 1)
        qp_b = q_pos.reshape(nb, Q_BLOCK)
        out = lax.map(block, (qn_b, qr_b, qp_b)).swapaxes(0, 1)
    else:
        out = block((q_nope, q_rope, q_pos))
    return out.reshape(B, Lq, MLA_WIDTH)


def pool_mix(u, hist, pos, pool_w, pool_scale):
    B, L, _ = u.shape
    P = POOL_HIST
    up = jnp.concatenate([hist.astype(u.dtype), u], axis=1)
    upf = up.astype(jnp.float32)
    cs = jnp.concatenate([jnp.zeros((B, 1, POOL_WIDTH), jnp.float32), jnp.cumsum(upf, axis=1)], axis=1)
    means = []
    for g, w in enumerate(POOL_WINDOWS):
        c0, c1 = g * POOL_GROUP_DIM, (g + 1) * POOL_GROUP_DIM
        tot = cs[:, P + 1:P + 1 + L, c0:c1] - cs[:, P + 1 - w:P + 1 - w + L, c0:c1]
        cnt = jnp.minimum(pos + 1, w).astype(jnp.float32)[None, :, None]
        means.append(tot / cnt)
    pooled = (jnp.concatenate(means, axis=-1) - upf[:, P:]).astype(u.dtype)
    y = jnp.einsum("blgc,gcd->blgd", pooled.reshape(B, L, len(POOL_WINDOWS), POOL_GROUP_DIM), pool_w)
    y = y.reshape(B, L, POOL_WIDTH) * pool_scale
    return y, up[:, -P:]


def band_chunks(t, n_chunks):
    pad = [(0, 0), (CA_WINDOW, 0)] + [(0, 0)] * (t.ndim - 2)
    tc = jnp.pad(t, pad).reshape((t.shape[0], n_chunks + CA_LEFT_CHUNKS, CHUNK) + t.shape[2:])
    return jnp.concatenate([tc[:, i:i + n_chunks] for i in range(CA_LEFT_CHUNKS + 1)], axis=2)


def ca_attend(q, k, v, q_pos, k_pos, rel_table):
    s = jnp.einsum("bnqhd,bnkhd->bnhqk", q, k).astype(jnp.float32) * CA_HEAD_DIM ** -0.5
    rel = jnp.clip(k_pos[:, None, :] - q_pos[:, :, None], -CA_MAX_REL, CA_MAX_REL) + CA_MAX_REL
    bias = jnp.transpose(rel_table.astype(jnp.float32)[:, rel], (1, 0, 2, 3))
    qc = (q_pos // CHUNK)[:, :, None]
    kc = (k_pos // CHUNK)[:, None, :]
    mask = (k_pos[:, None, :] >= 0) & (kc <= qc) & (kc >= qc - CA_LEFT_CHUNKS)
    s = jnp.where(mask[None, :, None], s + bias[None], NEG_INF)
    pr = jax.nn.softmax(s, axis=-1).astype(v.dtype)
    return jnp.einsum("bnhqk,bnkhd->bnqhd", pr, v)


def trunk_layer(x, ple, hist_ckv, hist_krope, hist_ck, hist_cv, hist_pool,
                norm_in, w_in, mla_q_norm, mla_w_uq, mla_kv_norm, mla_w_ukv, mla_qn_nope, mla_qn_rope,
                mla_kn_nope, mla_kn_rope, w_o_mla, pool_w, pool_scale, w_o_pool, ca_qn, ca_kn, ca_rel_bias,
                w_o_ca, w_out, ple_norm, w_ple_gate, w_ple_proj):
    B, L, _ = x.shape
    past = hist_ckv.shape[1]
    pos = past + jnp.arange(L)
    h = rmsnorm(x, norm_in)
    hq, hkv, g_a, u_b, g_b, qkv_c, g_c, g_mix = split_cols(h @ w_in)

    cq = rmsnorm(hq, mla_q_norm)
    q = (cq @ mla_w_uq).reshape(B, L, MLA_HEADS, MLA_NOPE + MLA_ROPE)
    q_nope = rmsnorm(q[..., :MLA_NOPE], mla_qn_nope)
    q_rope = rope(rmsnorm(q[..., MLA_NOPE:], mla_qn_rope), pos)
    ckv = rmsnorm(hkv[..., :MLA_KV_RANK], mla_kv_norm)
    krope = rope(rmsnorm(hkv[..., MLA_KV_RANK:], mla_kn_rope), pos)
    ckv_all = jnp.concatenate([hist_ckv.astype(ckv.dtype), ckv], axis=1)
    krope_all = jnp.concatenate([hist_krope.astype(krope.dtype), krope], axis=1)
    o_a = mla_attend(q_nope, q_rope, pos, ckv_all, krope_all, jnp.arange(past + L), mla_w_ukv, mla_kn_nope)
    o_a = o_a * jax.nn.silu(g_a)

    o_b, new_pool = pool_mix(u_b, hist_pool, pos, pool_w, pool_scale)
    o_b = o_b * jax.nn.silu(g_b)

    qkv = qkv_c.reshape(B, L, 3, CA_HEADS, CA_HEAD_DIM)
    qc = rmsnorm(qkv[:, :, 0], ca_qn)
    kc = rmsnorm(qkv[:, :, 1], ca_kn)
    vc = qkv[:, :, 2]
    if hist_ck is None:
        nc = L // CHUNK
        q_b = qc.reshape(B, nc, CHUNK, CA_HEADS, CA_HEAD_DIM)
        k_b = band_chunks(kc, nc)
        v_b = band_chunks(vc, nc)
        q_pos = pos.reshape(nc, CHUNK)
        kp = jnp.arange(-CA_WINDOW, L).reshape(nc + CA_LEFT_CHUNKS, CHUNK)
        k_pos = jnp.concatenate([kp[i:i + nc] for i in range(CA_LEFT_CHUNKS + 1)], axis=1)
        keep = min(CA_WINDOW, L)
        new_ck, new_cv = kc[:, L - keep:], vc[:, L - keep:]
    else:
        lc = hist_ck.shape[1]
        q_b = qc[:, None]
        k_b = jnp.concatenate([hist_ck.astype(kc.dtype), kc], axis=1)[:, None]
        v_b = jnp.concatenate([hist_cv.astype(vc.dtype), vc], axis=1)[:, None]
        q_pos = pos[None]
        k_pos = jnp.arange(past - lc, past + L)[None]
        new_ck, new_cv = kc, vc
    o_c = ca_attend(q_b, k_b, v_b, q_pos, k_pos, ca_rel_bias).reshape(B, L, CA_WIDTH)
    o_c = o_c * jax.nn.silu(g_c)

    gates = jax.nn.sigmoid(g_mix)
    m = (gates[..., :D_MODEL] * (o_a @ w_o_mla)
         + gates[..., D_MODEL:2 * D_MODEL] * (o_b @ w_o_pool)
         + gates[..., 2 * D_MODEL:] * (o_c @ w_o_ca))
    x = x + m @ w_out

    x = x + jax.nn.sigmoid(rmsnorm(x, ple_norm) @ w_ple_gate) * (ple @ w_ple_proj)
    return x, ckv, krope, new_ck, new_cv, new_pool


def setup_inputs(seed: int = 0) -> dict:
    key = jax.random.key(seed)
    ks = list(jax.random.split(key, 32))

    def nrm(shape, scale=1.0):
        return jax.random.normal(ks.pop(), shape, jnp.float32) * scale

    def gain(n):
        return 1.0 + nrm((DEPTH, n), 0.05)

    ca_keep = min(CA_WINDOW, PAST_LEN)
    return {
        "x_prompt": nrm((BATCH, SEQ, D_MODEL)),
        "x_sample": nrm((DEC_BATCH, DEC_SEQ, D_MODEL)),
        "cache_mla_ckv": nrm((DEPTH, DEC_BATCH, PAST_LEN, MLA_KV_RANK)),
        "cache_mla_krope": nrm((DEPTH, DEC_BATCH, PAST_LEN, MLA_ROPE)),
        "cache_ca_k": nrm((DEPTH, DEC_BATCH, ca_keep, CA_HEADS, CA_HEAD_DIM)),
        "cache_ca_v": nrm((DEPTH, DEC_BATCH, ca_keep, CA_HEADS, CA_HEAD_DIM)),
        "state_pool": nrm((DEPTH, DEC_BATCH, POOL_HIST, POOL_WIDTH)),
        "p_prompt": nrm((DEPTH, BATCH, SEQ, PLE_DIM)),
        "p_sample": nrm((DEPTH, DEC_BATCH, DEC_SEQ, PLE_DIM)),
        "norm_in": gain(D_MODEL),
        "w_in": nrm((DEPTH, D_MODEL, IN_TOTAL), D_MODEL ** -0.5),
        "mla_q_norm": gain(MLA_Q_RANK),
        "mla_w_uq": nrm((DEPTH, MLA_Q_RANK, MLA_HEADS * (MLA_NOPE + MLA_ROPE)), MLA_Q_RANK ** -0.5),
        "mla_kv_norm": gain(MLA_KV_RANK),
        "mla_w_ukv": nrm((DEPTH, MLA_KV_RANK, MLA_HEADS * (MLA_NOPE + MLA_V)), MLA_KV_RANK ** -0.5),
        "mla_qn_nope": gain(MLA_NOPE),
        "mla_qn_rope": gain(MLA_ROPE),
        "mla_kn_nope": gain(MLA_NOPE),
        "mla_kn_rope": gain(MLA_ROPE),
        "w_o_mla": nrm((DEPTH, MLA_WIDTH, D_MODEL), MLA_WIDTH ** -0.5),
        "pool_w": nrm((DEPTH, len(POOL_WINDOWS), POOL_GROUP_DIM, POOL_GROUP_DIM), POOL_GROUP_DIM ** -0.5),
        "pool_scale": 1.0 + nrm((DEPTH, POOL_WIDTH), 0.1),
        "w_o_pool": nrm((DEPTH, POOL_WIDTH, D_MODEL), POOL_WIDTH ** -0.5),
        "ca_qn": gain(CA_HEAD_DIM),
        "ca_kn": gain(CA_HEAD_DIM),
        "ca_rel_bias": nrm((DEPTH, CA_HEADS, 2 * CA_MAX_REL + 1), 0.1),
        "w_o_ca": nrm((DEPTH, CA_WIDTH, D_MODEL), CA_WIDTH ** -0.5),
        "w_out": nrm((DEPTH, D_MODEL, D_MODEL), D_MODEL ** -0.5),
        "ple_norm": gain(D_MODEL),
        "w_ple_gate": nrm((DEPTH, D_MODEL, D_MODEL), D_MODEL ** -0.5),
        "w_ple_proj": nrm((DEPTH, PLE_DIM, D_MODEL), PLE_DIM ** -0.5),
    }


def reference(x_prompt, x_sample, cache_mla_ckv, cache_mla_krope, cache_ca_k, cache_ca_v, state_pool,
              p_prompt, p_sample, norm_in, w_in, mla_q_norm, mla_w_uq, mla_kv_norm, mla_w_ukv,
              mla_qn_nope, mla_qn_rope, mla_kn_nope, mla_kn_rope, w_o_mla, pool_w, pool_scale, w_o_pool,
              ca_qn, ca_kn, ca_rel_bias, w_o_ca, w_out, ple_norm, w_ple_gate, w_ple_proj):
    xp, xs = x_prompt, x_sample
    B = xp.shape[0]
    st_p = [[], [], [], [], []]
    st_s = [[], [], [], [], []]
    for i in range(DEPTH):
        lw = (norm_in[i], w_in[i], mla_q_norm[i], mla_w_uq[i], mla_kv_norm[i], mla_w_ukv[i],
              mla_qn_nope[i], mla_qn_rope[i], mla_kn_nope[i], mla_kn_rope[i], w_o_mla[i],
              pool_w[i], pool_scale[i], w_o_pool[i], ca_qn[i], ca_kn[i], ca_rel_bias[i], w_o_ca[i],
              w_out[i], ple_norm[i], w_ple_gate[i], w_ple_proj[i])
        xp, ckv_p, kr_p, ck_p, cv_p, pl_p = trunk_layer(
            xp, p_prompt[i], jnp.zeros((B, 0, MLA_KV_RANK), xp.dtype), jnp.zeros((B, 0, MLA_ROPE), xp.dtype),
            None, None, jnp.zeros((B, POOL_HIST, POOL_WIDTH), xp.dtype), *lw)
        xs, ckv_s, kr_s, ck_s, cv_s, pl_s = trunk_layer(
            xs, p_sample[i], cache_mla_ckv[i], cache_mla_krope[i], cache_ca_k[i], cache_ca_v[i],
            state_pool[i], *lw)
        for lst, t in zip(st_p, (ckv_p, kr_p, ck_p, cv_p, pl_p)):
            lst.append(t)
        for lst, t in zip(st_s, (ckv_s, kr_s, ck_s, cv_s, pl_s)):
            lst.append(t)
    return (xp, xs,
            jnp.stack(st_p[0]), jnp.stack(st_p[1]), jnp.stack(st_p[2]), jnp.stack(st_p[3]), jnp.stack(st_p[4]),
            jnp.stack(st_s[0]), jnp.stack(st_s[1]), jnp.stack(st_s[2]), jnp.stack(st_s[3]), jnp.stack(st_s[4]))
```

```cpp
#include <hip/hip_runtime.h>
#include <hip/hip_cooperative_groups.h>
#include <cstdio>
#include <cstdint>
namespace cg = cooperative_groups;

#define LAS __attribute__((address_space(3)))
#define DI __device__ __forceinline__
typedef unsigned short bf16_t;
typedef short bf16x8 __attribute__((ext_vector_type(8)));
typedef float f32x2 __attribute__((ext_vector_type(2)));
typedef float f32x4 __attribute__((ext_vector_type(4)));
typedef float f32x16 __attribute__((ext_vector_type(16)));
typedef unsigned u32x2 __attribute__((ext_vector_type(2)));
typedef unsigned u32x4 __attribute__((ext_vector_type(4)));
typedef __bf16 bf16x2_t __attribute__((ext_vector_type(2)));

#ifndef STAGE_LIMIT
#define STAGE_LIMIT 99
#endif
#define REP_P0 1
#define REP_P2 1
#define REP_P3 1
#define REP_P4 1
#define REP_P5 1
#define REP_P6 1
#define DUP_KV 1
#define DUP_Q 1
#define DUP_CA 1
#define DUP_PROJ 1
#define REPLOOP(n) for (int rep_ = 0, reps_ = ((n) == 1 ? 1 : orep(n)); rep_ < reps_; ++rep_)

constexpr int MP = 65536, MS = 512, MROWS = MP + MS, MT = MROWS / 256;
constexpr int TP = 8192, TS = 64, PAST = 4096, TKS = PAST + TS;
constexpr int KVROWS = MP + 8 * TKS, KVT = KVROWS / 256;
constexpr int CAKS = 512 + TS;
constexpr float EPSF = 1e-6f;
constexpr float LOG2E = 1.4426950408889634f;
constexpr float QSCALE_MLA = 0.10206207261596577f * LOG2E;
constexpr float QSCALE_CA = 0.125f * LOG2E;

constexpr size_t O_Y = 0;
constexpr size_t O_CKVP = (size_t)MROWS * 1024;
constexpr size_t O_KRP = O_CKVP + (size_t)2 * 8 * 8192 * 128;
constexpr size_t O_CKP = O_KRP + (size_t)2 * 8 * 8192 * 32;
constexpr size_t O_CVP = O_CKP + (size_t)2 * 8 * 512 * 256;
constexpr size_t O_PLP = O_CVP + (size_t)2 * 8 * 512 * 256;
constexpr size_t O_CKVS = O_PLP + (size_t)2 * 8 * 15 * 256;
constexpr size_t O_KRS = O_CKVS + (size_t)2 * 8 * 64 * 128;
constexpr size_t O_CKS = O_KRS + (size_t)2 * 8 * 64 * 32;
constexpr size_t O_CVS = O_CKS + (size_t)2 * 8 * 64 * 256;
constexpr size_t O_PLS = O_CVS + (size_t)2 * 8 * 64 * 256;
constexpr size_t O_END = O_PLS + (size_t)2 * 8 * 15 * 256;

constexpr size_t AL(size_t x) { return (x + 255) & ~(size_t)255; }
constexpr size_t WL_WIN = 0;
constexpr size_t WL_WUQ = WL_WIN + (size_t)5632 * 1024 * 2;
constexpr size_t WL_WUK = WL_WUQ + (size_t)768 * 256 * 2;
constexpr size_t WL_WUV = WL_WUK + (size_t)512 * 128 * 2;
constexpr size_t WL_WPOOL = WL_WUV + (size_t)512 * 128 * 2;
constexpr size_t WL_WCAT = WL_WPOOL + (size_t)256 * 256 * 2;
constexpr size_t WL_WOUT = WL_WCAT + (size_t)1024 * 1024 * 2;
constexpr size_t WL_WPG = WL_WOUT + (size_t)1024 * 1024 * 2;
constexpr size_t WL_WPROJ = WL_WPG + (size_t)1024 * 1024 * 2;
constexpr size_t WL_SIZE = WL_WPROJ + (size_t)1024 * 256 * 2;
constexpr size_t WS_W = 0;
constexpr size_t WS_CS = AL(WS_W + 2 * WL_SIZE);
constexpr size_t WS_XB = AL(WS_CS + (size_t)8192 * 32 * 4);
constexpr size_t WS_SSQX = AL(WS_XB + (size_t)MROWS * 1024 * 2);
constexpr size_t WS_SSQ1 = AL(WS_SSQX + (size_t)MROWS * 16 * 4);
constexpr size_t WS_SSQQ = AL(WS_SSQ1 + (size_t)MROWS * 16 * 4);
constexpr size_t WS_G1 = AL(WS_SSQQ + (size_t)MROWS * 4 * 4);
constexpr size_t G1_HQ = 0;
constexpr size_t G1_HKV = AL(G1_HQ + (size_t)MROWS * 256 * 2);
constexpr size_t G1_QC = AL(G1_HKV + (size_t)MROWS * 160 * 4);
constexpr size_t G1_KC = AL(G1_QC + (size_t)MROWS * 256 * 2);
constexpr size_t G1_VCT = AL(G1_KC + (size_t)MROWS * 256 * 2);
constexpr size_t G1_UB = AL(G1_VCT + (size_t)8 * 256 * 8192 * 2);
constexpr size_t G1_GC = AL(G1_UB + (size_t)MROWS * 256 * 2);
constexpr size_t G1_ENDA = AL(G1_GC + (size_t)MROWS * 256 * 2);
constexpr size_t G1_KP = 0;
constexpr size_t G1_KPS = AL(G1_KP + (size_t)8 * 8 * 8192 * 96 * 2);
constexpr size_t G1_VT = AL(G1_KPS + (size_t)8 * 8 * TKS * 96 * 2);
constexpr size_t G1_VTS = AL(G1_VT + (size_t)8 * 512 * 8192 * 2);
constexpr size_t G1_ENDB = AL(G1_VTS + (size_t)8 * 512 * TKS * 2);
constexpr size_t G1_MB = 0;
constexpr size_t G1_SIZE = G1_ENDA > G1_ENDB ? G1_ENDA : G1_ENDB;
constexpr size_t WS_R2 = AL(WS_G1 + G1_SIZE);
constexpr size_t R2_QP = 0;
constexpr size_t R2_GA = AL(R2_QP + (size_t)MROWS * 768 * 2);
constexpr size_t R2_SIZE = AL(R2_GA + (size_t)MROWS * 512 * 2);
constexpr size_t WS_GB = AL(WS_R2 + R2_SIZE);
constexpr size_t WS_POOLED = AL(WS_GB + (size_t)MROWS * 256 * 2);
constexpr size_t WS_OCAT = AL(WS_POOLED + (size_t)MROWS * 256 * 2);
constexpr size_t WS_CKVB = AL(WS_OCAT + (size_t)MROWS * 1024 * 2);
constexpr size_t WS_KRB = AL(WS_CKVB + (size_t)KVROWS * 128 * 2);
constexpr size_t WS_KCS = AL(WS_KRB + (size_t)KVROWS * 32 * 2);
constexpr size_t WS_VCTS = AL(WS_KCS + (size_t)2 * 8 * CAKS * 256 * 2);
constexpr size_t WS_PB = AL(WS_VCTS + (size_t)2 * 8 * 256 * CAKS * 2);
constexpr size_t WS_BAR = AL(WS_PB + (size_t)MROWS * 256 * 2);
constexpr size_t WS_PART = AL(WS_BAR + 3456 * 4);
constexpr size_t WS_GMS = AL(WS_PART + (size_t)256 * 64 * 66 * 4);
constexpr size_t WS_END = AL(WS_GMS + (size_t)MS * 3072 * 2);
constexpr size_t P6_SCR_PER_WG = 2 * 128 * 1024;
static_assert(256 * P6_SCR_PER_WG <= R2_SIZE, "P6 scratch must fit region 2");
static_assert((size_t)MROWS * 1024 * 2 <= R2_SIZE, "PROJ must fit region 2");
static_assert((size_t)MROWS * 1024 * 2 <= G1_SIZE, "MB must fit region 1");

constexpr int LDS_BYTES = 144 * 1024;

struct Params {
  const float* in[31];
  float* out;
  unsigned char* ws;
  int G, pad;
};

#define GAS __attribute__((address_space(1)))
template <class T> DI T* GP(T* p) { return p; }
DI int orep2(int n) { asm volatile("" : "+s"(n)); return n; }
DI void stagger_odd(int vcu, int n) { if (vcu & 1) { for (int i = 0, m = orep2(n); i < m; ++i) __builtin_amdgcn_s_sleep(127); } }
DI int orep(int n) { asm volatile("" : "+s"(n)); return n; }
DI int otid() { int t = threadIdx.x; asm volatile("" : "+v"(t)); return t; }
DI int obid() { int t = blockIdx.x; asm volatile("" : "+s"(t)); return t; }
DI int ogdim() { int t = gridDim.x; asm volatile("" : "+s"(t)); return t; }
DI unsigned pk2(float lo, float hi) { f32x2 v = {lo, hi}; bf16x2_t b = __builtin_convertvector(v, bf16x2_t); return __builtin_bit_cast(unsigned, b); }
DI float bflo(unsigned u) { return __uint_as_float(u << 16); }
DI float bfhi(unsigned u) { return __uint_as_float(u & 0xffff0000u); }
DI float sigmoidf_(float x) { return __builtin_amdgcn_rcpf(1.0f + __builtin_amdgcn_exp2f(-x * LOG2E)); }
DI float siluf_(float x) { return x * sigmoidf_(x); }
typedef _Float16 h2_t __attribute__((ext_vector_type(2)));
DI unsigned pkh(float a, float b) { return __builtin_bit_cast(unsigned, __builtin_amdgcn_cvt_pkrtz(a, b)); }
DI float hlo(unsigned u) { const h2_t h = __builtin_bit_cast(h2_t, u); return (float)h[0]; }
DI float hhi(unsigned u) { const h2_t h = __builtin_bit_cast(h2_t, u); return (float)h[1]; }
DI u32x4 pack8h(const f32x4 a, const f32x4 b) { u32x4 w; w.x = pkh(a[0], a[1]); w.y = pkh(a[2], a[3]); w.z = pkh(b[0], b[1]); w.w = pkh(b[2], b[3]); return w; }
DI void unpack8h(const u32x4 w, f32x4& a, f32x4& b) { a[0] = hlo(w.x); a[1] = hhi(w.x); a[2] = hlo(w.y); a[3] = hhi(w.y); b[0] = hlo(w.z); b[1] = hhi(w.z); b[2] = hlo(w.w); b[3] = hhi(w.w); }
DI u32x4 pack8(const f32x4 a, const f32x4 b) { u32x4 w; w.x = pk2(a[0], a[1]); w.y = pk2(a[2], a[3]); w.z = pk2(b[0], b[1]); w.w = pk2(b[2], b[3]); return w; }
DI float rstd16(const float* p, float invn) {
  const f32x4 a = *(const GAS f32x4*)p, b = *(const GAS f32x4*)(p + 4), c = *(const GAS f32x4*)(p + 8), d = *(const GAS f32x4*)(p + 12);
  const float s = ((a[0] + a[1]) + (a[2] + a[3])) + ((b[0] + b[1]) + (b[2] + b[3])) + ((c[0] + c[1]) + (c[2] + c[3])) + ((d[0] + d[1]) + (d[2] + d[3]));
  return __builtin_amdgcn_rsqf(s * invn + EPSF);
}
template <int K> DI float swz_xor(float v) { return __builtin_bit_cast(float, __builtin_amdgcn_ds_swizzle(__builtin_bit_cast(int, v), 0x1F | (K << 10))); }
DI float sum_xor32(float v) { auto r = __builtin_amdgcn_permlane32_swap(__float_as_uint(v), __float_as_uint(v), false, false); return __uint_as_float(r[0]) + __uint_as_float(r[1]); }
DI float max_xor32(float v) { auto r = __builtin_amdgcn_permlane32_swap(__float_as_uint(v), __float_as_uint(v), false, false); return fmaxf(__uint_as_float(r[0]), __uint_as_float(r[1])); }
DI float get_xor32(float v, bool upper) { auto r = __builtin_amdgcn_permlane32_swap(__float_as_uint(v), __float_as_uint(v), false, false); return __uint_as_float(upper ? r[0] : r[1]); }
DI float red_fq(float s) { s += swz_xor<16>(s); return sum_xor32(s); }
DI float wave_sum(float s) { s += swz_xor<1>(s); s += swz_xor<2>(s); s += swz_xor<4>(s); s += swz_xor<8>(s); s += swz_xor<16>(s); return sum_xor32(s); }
DI void rstd8(const float* SSQ, int rowbase, int fq, float invn, float (&rs)[8]) {
  f32x4 q[8];
#pragma unroll
  for (int k = 0; k < 8; ++k) q[k] = *(const GAS f32x4*)(SSQ + (size_t)(rowbase + 128 * (k >> 2) + 16 * (k & 3)) * 16 + 4 * fq);
#pragma unroll
  for (int k = 0; k < 8; ++k) rs[k] = __builtin_amdgcn_rsqf(red_fq((q[k][0] + q[k][1]) + (q[k][2] + q[k][3])) * invn + EPSF);
}
DI float ss4(const f32x4 v) { return (v[0] * v[0] + v[1] * v[1]) + (v[2] * v[2] + v[3] * v[3]); }

namespace pg8 {
constexpr int BM = 256, BK = 64, HALF = 128, HTB = HALF * BK * 2, STAGE_BYTES = 8 * HTB;
DI int lds_byte(int r, int c) { const int st = (r >> 4) * 2 + (c >> 5), rr = r & 15, cc = c & 31, ob = rr * 64 + cc * 2; return st * 1024 + (ob ^ (((ob >> 9) & 1) << 5)); }
DI void stage_rc(int b, int& R, int& C) { const int st = b / 1024, sb = b % 1024, swz = sb ^ (((sb >> 9) & 1) << 5); R = (st >> 1) * 16 + swz / 64; C = (st & 1) * 32 + (swz % 64) / 2; }
DI int perm32(int rho) { const int n = rho >> 4, i = rho & 15; return 8 * (i >> 2) + 4 * n + (i & 3); }
struct Unit { const char* A; const char* B; int nt, pm, pn, kind; };
template <class Epi, class Sched>
DI void gemm_phase(LAS unsigned char* lds, const int lda, const int ldb, const Sched& S, const Epi& E) {
  const int tid = otid(), wid = __builtin_amdgcn_readfirstlane(tid >> 6), lane = tid & 63, wr = wid >> 2, wc = wid & 3, fr = lane & 15, fq = lane >> 4;
  unsigned voffA[2], voffB[2];
#pragma unroll
  for (int i = 0; i < 2; ++i) { int R, C; stage_rc(tid * 16 + i * 8192, R, C); const int Rb = (R & ~31) + perm32(R & 31);
    voffA[i] = (unsigned)(R * lda + C * 2); voffB[i] = (unsigned)(Rb * ldb + C * 2); }
  const size_t kstep = (size_t)(BK * 2);
  const size_t hsA = (size_t)HALF * lda, hsB = (size_t)HALF * ldb;
  const unsigned ldsw = (unsigned)wid * 1024u;
  const int aoff = lds_byte(wr * 64 + fr, fq * 8), boff = lds_byte(wc * 32 + fr, fq * 8);
#define PG8_SA(b, h) (((b) * 2 + (h)) * HTB)
#define PG8_SB(b, h) ((4 + (b) * 2 + (h)) * HTB)
#define PG8_STAGE(bufoff, gbase, voff) do { _Pragma("unroll") for (int _i = 0; _i < 2; ++_i) \
    __builtin_amdgcn_global_load_lds((const unsigned*)((const char*)(gbase) + (voff)[_i]), (LAS unsigned*)(lds + (bufoff) + ldsw + _i * 8192), 16, 0, 0); } while (0)
#define PG8_LDA(dst, b, h) do { _Pragma("unroll") for (int m = 0; m < 4; ++m) _Pragma("unroll") for (int k = 0; k < 2; ++k) dst[m][k] = *(const LAS bf16x8*)(lds + PG8_SA(b, h) + aoff + m * 2048 + k * 1024); } while (0)
#define PG8_LDB(dst, b, h) do { _Pragma("unroll") for (int n = 0; n < 2; ++n) _Pragma("unroll") for (int k = 0; k < 2; ++k) dst[n][k] = *(const LAS bf16x8*)(lds + PG8_SB(b, h) + boff + n * 2048 + k * 1024); } while (0)
#define PG8_MMA(ai, bj, At, Bt) do { __builtin_amdgcn_s_setprio(1); _Pragma("unroll") for (int m = 0; m < 4; ++m) _Pragma("unroll") for (int n = 0; n < 2; ++n) _Pragma("unroll") for (int k = 0; k < 2; ++k) \
    acc[ai][bj][m][n] = __builtin_amdgcn_mfma_f32_16x16x32_bf16(Bt[n][k], At[m][k], acc[ai][bj][m][n], 0, 0, 0); __builtin_amdgcn_s_setprio(0); } while (0)
#define PG8_WAIT_V(n) asm volatile("s_waitcnt vmcnt(" #n ")" ::: "memory")
#define PG8_WAIT_L(n) asm volatile("s_waitcnt lgkmcnt(" #n ")" ::: "memory")
#define PG8_BAR __builtin_amdgcn_s_barrier()
#define PG8_SCHED __builtin_amdgcn_sched_barrier(0)
  Unit cur, nxt; int ui = 0;
  if (!S.next(0, cur)) return;
  f32x4 acc[2][2][4][2];
#pragma unroll
  for (int a = 0; a < 2; ++a)
#pragma unroll
    for (int b = 0; b < 2; ++b)
#pragma unroll
      for (int m = 0; m < 4; ++m)
#pragma unroll
        for (int n = 0; n < 2; ++n) acc[a][b][m][n] = (f32x4){0.f, 0.f, 0.f, 0.f};
  bf16x8 At[4][2], B0[2][2], B1[2][2];
  const char* cA = cur.A; const char* cB = cur.B;
  PG8_STAGE(PG8_SB(0, 0), cB, voffB); PG8_STAGE(PG8_SB(0, 1), cB + hsB, voffB); PG8_STAGE(PG8_SA(0, 0), cA, voffA); PG8_STAGE(PG8_SA(0, 1), cA + hsA, voffA);
  if (wr == 1) PG8_BAR;
  PG8_WAIT_V(2); PG8_BAR;
  PG8_STAGE(PG8_SB(1, 0), cB + kstep, voffB); PG8_STAGE(PG8_SA(1, 0), cA + kstep, voffA); PG8_STAGE(PG8_SB(1, 1), cB + hsB + kstep, voffB);
  PG8_WAIT_V(6); PG8_BAR;
  for (;;) {
    const bool has_next = S.next(ui + 1, nxt);
    const char* nA = has_next ? nxt.A : cA; const char* nB = has_next ? nxt.B : cB;
    const int nt = cur.nt;
    for (int t = 0; t < nt; t += 2) {
      const bool last = (t == nt - 2);
      asm volatile("" : "+v"(voffA[0]), "+v"(voffA[1]), "+v"(voffB[0]), "+v"(voffB[1]));
      const char* a1 = cA + (size_t)(t + 1) * kstep;
      const char* a2 = last ? nA : cA + (size_t)(t + 2) * kstep; const char* b2 = last ? nB : cB + (size_t)(t + 2) * kstep;
      const char* a3 = a2 + kstep; const char* b3 = b2 + kstep;
      PG8_LDB(B0, 0, 0); PG8_LDB(B1, 0, 1); PG8_SCHED; PG8_LDA(At, 0, 0); PG8_STAGE(PG8_SA(1, 1), a1 + hsA, voffA);
      PG8_WAIT_V(8); PG8_WAIT_L(0); PG8_BAR; PG8_MMA(0, 0, At, B0); PG8_MMA(0, 1, At, B1); PG8_BAR; PG8_SCHED;
      PG8_LDA(At, 0, 1); PG8_STAGE(PG8_SB(0, 0), b2, voffB); PG8_STAGE(PG8_SB(0, 1), b2 + hsB, voffB); PG8_STAGE(PG8_SA(0, 0), a2, voffA);
      PG8_WAIT_V(8); PG8_WAIT_L(0); PG8_BAR; PG8_MMA(1, 0, At, B0); PG8_MMA(1, 1, At, B1); PG8_BAR; PG8_SCHED;
      PG8_LDB(B0, 1, 0); PG8_LDB(B1, 1, 1); PG8_SCHED; PG8_LDA(At, 1, 0); PG8_STAGE(PG8_SA(0, 1), a2 + hsA, voffA);
      PG8_WAIT_V(8); PG8_WAIT_L(0); PG8_BAR; PG8_MMA(0, 0, At, B0); PG8_MMA(0, 1, At, B1); PG8_BAR; PG8_SCHED;
      PG8_LDA(At, 1, 1); PG8_STAGE(PG8_SB(1, 0), b3, voffB); PG8_STAGE(PG8_SB(1, 1), b3 + hsB, voffB); PG8_STAGE(PG8_SA(1, 0), a3, voffA);
      PG8_WAIT_V(8); PG8_WAIT_L(0); PG8_BAR; PG8_MMA(1, 0, At, B0); PG8_MMA(1, 1, At, B1); PG8_BAR; PG8_SCHED;
    }
    if (wr == 0) PG8_BAR;
    { const int t2 = otid(), w2 = __builtin_amdgcn_readfirstlane(t2 >> 6), l2 = t2 & 63; E(acc, cur, w2 >> 2, w2 & 3, l2 & 15, l2 >> 4); }
    if (!has_next) break;
#pragma unroll
    for (int a = 0; a < 2; ++a)
#pragma unroll
      for (int b = 0; b < 2; ++b)
#pragma unroll
        for (int m = 0; m < 4; ++m)
#pragma unroll
          for (int n = 0; n < 2; ++n) acc[a][b][m][n] = (f32x4){0.f, 0.f, 0.f, 0.f};
    cur = nxt; cA = nA; cB = nB; ++ui;
    if (wr == 1) PG8_BAR;
  }
  PG8_WAIT_V(0);
  PG8_BAR;
#undef PG8_SA
#undef PG8_SB
#undef PG8_STAGE
#undef PG8_LDA
#undef PG8_LDB
#undef PG8_MMA
#undef PG8_WAIT_V
#undef PG8_WAIT_L
#undef PG8_BAR
#undef PG8_SCHED
}
}
using pg8::Unit;
typedef f32x4 Acc[2][2][4][2];

struct Frame {
  const Params* P;
  float* out;
  unsigned char* ws;
  int G, vcu, layer;
  DI const float* in(int idx) const { return GP(P->in[idx]); }
  DI const float* lin(int idx, size_t per_layer) const { return GP(P->in[idx]) + (size_t)layer * per_layer; }
  DI unsigned char* W() const { return GP(ws); }
  DI float* O() const { return GP(out); }
  DI unsigned char* wl(size_t off) const { return GP(ws) + WS_W + (size_t)layer * WL_SIZE + off; }
  DI unsigned char* g1(size_t off) const { return GP(ws) + WS_G1 + off; }
  DI unsigned char* r2(size_t off) const { return GP(ws) + WS_R2 + off; }
};

DI int map_col(int kind, int base, int r) {
  switch (kind) {
    case 0: return base + r;
    case 1: {
      if (r < 256) return r;
      if (r < 512) { const int c = r - 256; return c < 160 ? 256 + c : -1; }
      if (r < 1024) return 416 + (r - 512);
      if (r < 1280) return 928 + (r - 1024);
      if (r < 1536) return 1184 + (r - 1280);
      if (r < 2048) { const int c = (r - 1536) & 255, bj = c >> 7, wc = (c >> 5) & 3, j = c & 31; return (r < 1792 ? 1440 : 1696) + wc * 64 + 32 * bj + j; }
      if (r < 2304) return 2208 + (r - 2048);
      if (r < 2560) return 1952 + (r - 2304);
      return 2464 + (r - 2560);
    }
    case 2: {
      const int pn = r >> 8, c = r & 255, bj = c >> 7, wc = (c >> 5) & 3, j = c & 31;
      if (pn < 2) return (4 * pn + wc) * 96 + 32 * bj + j;
      return (2 * wc + bj) * 96 + 64 + j;
    }
    case 3: {
      const int pn = r >> 8, c = r & 255, bj = c >> 7, wc = (c >> 5) & 3, j = c & 31;
      return (4 * pn + wc) * 128 + 32 * bj + j;
    }
    default: return (r >> 6) * 128 + 64 + (r & 63);
  }
}
struct PrepJob { int dst_off_lo, dst_off_hi; int ldd, koff, src, nsrc, K, nrows, kind, base, gain; };
__device__ const int PREP_JOBS[9][10] = {
  {(int)WL_WIN, 1024, 0, 10, 5536, 1024, 5632, 1, 0, 9},
  {(int)WL_WUQ, 256, 0, 12, 768, 256, 768, 2, 0, 11},
  {(int)WL_WUK, 128, 0, 14, 1024, 128, 512, 3, 0, -1},
  {(int)WL_WUV, 128, 0, 14, 1024, 128, 512, 4, 0, -1},
  {(int)WL_WCAT, 1024, 0, 19, 1024, 512, 1024, 0, 0, -1},
  {(int)WL_WCAT, 1024, 512, 22, 1024, 256, 1024, 0, 0, -1},
  {(int)WL_WCAT, 1024, 768, 26, 1024, 256, 1024, 0, 0, -1},
  {(int)WL_WOUT, 1024, 0, 27, 1024, 1024, 1024, 0, 0, -1},
  {(int)WL_WPG, 1024, 0, 29, 1024, 1024, 1024, 0, 0, 28},
};
DI void prep_weights(const Frame& F, LAS unsigned char* lds) {
  LAS float* T = (LAS float*)lds;
  const int tid = otid(), bid = obid(), gdim = ogdim();
  for (int layer = 0; layer < 2; ++layer) {
    for (int j = 0; j < 10; ++j) {
      int dsto, ldd, koff, src, nsrc, K, nrows, kind, base, gain;
      if (j < 9) { dsto = PREP_JOBS[j][0]; ldd = PREP_JOBS[j][1]; koff = PREP_JOBS[j][2]; src = PREP_JOBS[j][3]; nsrc = PREP_JOBS[j][4]; K = PREP_JOBS[j][5]; nrows = PREP_JOBS[j][6]; kind = PREP_JOBS[j][7]; base = PREP_JOBS[j][8]; gain = PREP_JOBS[j][9]; }
      else { dsto = (int)WL_WPROJ; ldd = 256; koff = 0; src = 30; nsrc = 1024; K = 256; nrows = 1024; kind = 0; base = 0; gain = -1; }
      const float* W = F.in(src) + (size_t)layer * K * nsrc;
      const float* gv = gain >= 0 ? F.in(gain) + (size_t)layer * K : nullptr;
      bf16_t* dst = (bf16_t*)(F.W() + WS_W + (size_t)layer * WL_SIZE + dsto);
      const int tk = K / 64, tn = nrows / 64, ntile = tk * tn;
      for (int tix = bid; tix < ntile; tix += gdim) {
        const int n0 = (tix / tk) * 64, k0 = (tix % tk) * 64;
        const int nx = tid & 63, ky0 = tid >> 6;
        const int col = map_col(kind, base, n0 + nx);
        const int colc = col >= 0 ? col : 0; const float mk = col >= 0 ? 1.0f : 0.0f;
        float vals[8];
#pragma unroll
        for (int i = 0; i < 8; ++i) vals[i] = *(const GAS float*)(W + (size_t)(k0 + ky0 + 8 * i) * nsrc + colc);
        if (gv) {
#pragma unroll
          for (int i = 0; i < 8; ++i) vals[i] *= *(const GAS float*)(gv + k0 + ky0 + 8 * i);
        }
#pragma unroll
        for (int i = 0; i < 8; ++i) T[(ky0 + 8 * i) * 65 + nx] = vals[i] * mk;
        __syncthreads();
        const int ny = tid >> 3, ks = (tid & 7) * 8;
        u32x4 w;
        w.x = pk2(T[(ks + 0) * 65 + ny], T[(ks + 1) * 65 + ny]); w.y = pk2(T[(ks + 2) * 65 + ny], T[(ks + 3) * 65 + ny]);
        w.z = pk2(T[(ks + 4) * 65 + ny], T[(ks + 5) * 65 + ny]); w.w = pk2(T[(ks + 6) * 65 + ny], T[(ks + 7) * 65 + ny]);
        *(GAS u32x4*)(dst + (size_t)(n0 + ny) * ldd + koff + k0 + ks) = w;
        __syncthreads();
      }
    }
    {
      bf16_t* dst = (bf16_t*)(F.W() + WS_W + (size_t)layer * WL_SIZE + WL_WPOOL);
      const float* pw = F.in(20) + (size_t)layer * 4 * 64 * 64; const float* ps = F.in(21) + (size_t)layer * 256;
      for (int e = bid * 512 + tid; e < 256 * 256; e += gdim * 512) {
        const int n = e >> 8, k = e & 255;
        float v = 0.f;
        if ((n >> 6) == (k >> 6)) v = pw[((n >> 6) * 64 + (k & 63)) * 64 + (n & 63)] * ps[n];
        dst[e] = (bf16_t)(pk2(v, 0.f) & 0xffffu);
      }
    }
  }
}

DI void prep_misc(const Frame& F) {
  const int tid = otid(), lane = tid & 63, bid = obid(), gdim = ogdim();
  const int gw = bid * 8 + (tid >> 6), nw = gdim * 8;
  bf16_t* XB = (bf16_t*)(F.W() + WS_XB); float* SSQX = (float*)(F.W() + WS_SSQX);
  for (int row = gw; row < MROWS; row += nw) {
    const float* x = row < MP ? F.in(0) + (size_t)row * 1024 : F.in(1) + (size_t)(row - MP) * 1024;
    float s = 0.f;
    f32x4 v4[4];
#pragma unroll
    for (int i = 0; i < 4; ++i) v4[i] = *(const GAS f32x4*)(x + i * 256 + lane * 4);
#pragma unroll
    for (int i = 0; i < 4; ++i) {
      const f32x4 v = v4[i];
      s += ss4(v);
      u32x2 w; w.x = pk2(v[0], v[1]); w.y = pk2(v[2], v[3]);
      *(GAS u32x2*)(XB + (size_t)row * 1024 + i * 256 + lane * 4) = w;
    }
    s = wave_sum(s);
    if (lane < 16) SSQX[(size_t)row * 16 + lane] = lane == 0 ? s : 0.f;
  }
  float* CS = (float*)(F.W() + WS_CS);
  for (int e = bid * 512 + tid; e < 8192 * 16; e += gdim * 512) {
    const int pos = e >> 4, i = e & 15;
    const double inv = exp2(-(double)i * (13.287712379549449 / 16.0));
    double rev = (double)pos * inv * 0.15915494309189535;
    rev -= floor(rev);
    const float fr = (float)rev;
    CS[pos * 32 + i] = __builtin_amdgcn_cosf(fr);
    CS[pos * 32 + 16 + i] = __builtin_amdgcn_sinf(fr);
  }
  bf16_t* KCS = (bf16_t*)(F.W() + WS_KCS); bf16_t* VCTS = (bf16_t*)(F.W() + WS_VCTS);
  for (int e = bid * 512 + tid; e < 2 * 8 * 512 * 256; e += gdim * 512) {
    const int c = e & 255, t = (e >> 8) & 511, lb = e >> 17;
    const float kv = F.in(4)[e], vv = F.in(5)[e];
    KCS[((size_t)lb * CAKS + t) * 256 + c] = (bf16_t)(pk2(kv, 0.f) & 0xffffu);
    VCTS[((size_t)lb * 256 + c) * CAKS + t] = (bf16_t)(pk2(vv, 0.f) & 0xffffu);
  }
}

DI void conv_layer(const Frame& F) {
  const int tid = otid();
  const size_t gt = (size_t)obid() * 512 + tid, gn = (size_t)ogdim() * 512;
  GAS bf16_t* PB = (GAS bf16_t*)(F.W() + WS_PB);
  const GAS float* pp = (const GAS float*)F.in(7) + (size_t)F.layer * MP * 256; const GAS float* psm = (const GAS float*)F.in(8) + (size_t)F.layer * MS * 256;
  for (size_t e0 = gt; e0 < (size_t)MROWS * 64; e0 += 4 * gn) {
    f32x4 v[4];
#pragma unroll
    for (int k = 0; k < 4; ++k) { const size_t e = e0 + k * gn; const size_t row = e >> 6; const int c = (int)(e & 63) * 4;
      v[k] = e < (size_t)MROWS * 64 ? (row < MP ? *(const GAS f32x4*)(pp + row * 256 + c) : *(const GAS f32x4*)(psm + (row - MP) * 256 + c)) : (f32x4){0.f, 0.f, 0.f, 0.f}; }
#pragma unroll
    for (int k = 0; k < 4; ++k) { const size_t e = e0 + k * gn; if (e >= (size_t)MROWS * 64) break; const size_t row = e >> 6; const int c = (int)(e & 63) * 4;
      u32x2 w; w.x = pk2(v[k][0], v[k][1]); w.y = pk2(v[k][2], v[k][3]);
      *(GAS u32x2*)(PB + row * 256 + c) = w; }
  }
  GAS bf16_t* CKVB = (GAS bf16_t*)(F.W() + WS_CKVB); GAS bf16_t* KRB = (GAS bf16_t*)(F.W() + WS_KRB);
  const GAS float* cc = (const GAS float*)F.in(2) + (size_t)F.layer * 8 * PAST * 128; const GAS float* ck = (const GAS float*)F.in(3) + (size_t)F.layer * 8 * PAST * 32;
  for (size_t e0 = gt; e0 < (size_t)8 * PAST * 32; e0 += 4 * gn) {
    f32x4 v[4];
#pragma unroll
    for (int k = 0; k < 4; ++k) { const size_t e = e0 + k * gn; v[k] = e < (size_t)8 * PAST * 32 ? *(const GAS f32x4*)(cc + (e >> 5) * 128 + (int)(e & 31) * 4) : (f32x4){0.f, 0.f, 0.f, 0.f}; }
#pragma unroll
    for (int k = 0; k < 4; ++k) { const size_t e = e0 + k * gn; if (e >= (size_t)8 * PAST * 32) break;
      const size_t tok = e >> 5; const int c = (int)(e & 31) * 4; const size_t b = tok >> 12, t = tok & 4095;
      u32x2 w; w.x = pk2(v[k][0], v[k][1]); w.y = pk2(v[k][2], v[k][3]);
      *(GAS u32x2*)(CKVB + ((size_t)MP + b * TKS + t) * 128 + c) = w; }
  }
  for (size_t e = gt; e < (size_t)8 * PAST * 8; e += gn) {
    const size_t tok = e >> 3; const int c = (int)(e & 7) * 4; const size_t b = tok >> 12, t = tok & 4095;
    const f32x4 v = *(const GAS f32x4*)(ck + tok * 32 + c);
    u32x2 w; w.x = pk2(v[0], v[1]); w.y = pk2(v[2], v[3]);
    *(GAS u32x2*)(KRB + ((size_t)MP + b * TKS + t) * 32 + c) = w;
  }
}

#define FENCE() asm volatile("" ::: "memory")
#define OPAQUE(p) do { asm volatile("" : "+s"(p)); p = GP(p); } while (0)
struct SchedZ {
  const unsigned char* ws; int layer, G, vcu;
  DI bool next(int i, Unit& u) const {
    const int L = i * G + vcu; if (L >= MT * 10 + 24) return false;
    const char* XB = (const char*)(ws + WS_XB); const char* WIN = (const char*)(ws + WS_W + (size_t)layer * WL_SIZE + WL_WIN);
    u.nt = 16;
    if (L >= MT * 10) {
      const int idx = L - MT * 10, tile = idx / 3, gi = idx - tile * 3;
      u.pm = 256 + (tile >> 2); u.pn = tile & 3; u.kind = 10 + gi;
      u.A = XB + (size_t)u.pm * 256 * 2048; u.B = WIN + (size_t)(2560 + gi * 1024 + u.pn * 256) * 2048; return true;
    }
    const int pm = L / 10, k = L % 10;
    u.kind = k;
    if (k < 9) { u.A = XB + (size_t)pm * 256 * 2048; u.B = WIN + (size_t)k * 256 * 2048; u.pm = pm; u.pn = k; }
    else { u.A = WIN + (size_t)2304 * 2048; u.B = XB + (size_t)pm * 256 * 2048; u.pm = 0; u.pn = pm; }
    return true;
  }
};
struct EpiZ {
  const Params* P; int layer;
  template <int kind>
  DI void rows(Acc& acc, const Unit& u, int wr, int wc, int fr, int fq, unsigned char* ws, float* out, const float (&rs8)[8]) const {
    f32x4 gq[2][2] = {};
    if (kind == 6 || kind == 7) {
      const float* gn = GP(kind == 6 ? P->in[23] : P->in[24]) + layer * 64;
#pragma unroll
      for (int bj = 0; bj < 2; ++bj) { gq[bj][0] = *(const GAS f32x4*)(gn + 32 * bj + 8 * fq); gq[bj][1] = *(const GAS f32x4*)(gn + 32 * bj + 8 * fq + 4); }
    }
#pragma unroll
    for (int ai = 0; ai < 2; ++ai)
#pragma unroll
      for (int m = 0; m < 4; ++m) {
        const int row = u.pm * 256 + 128 * ai + 64 * wr + 16 * m + fr;
        const float rs = rs8[ai * 4 + m];
        f32x4 v[2][2];
#pragma unroll
        for (int bj = 0; bj < 2; ++bj)
#pragma unroll
          for (int n = 0; n < 2; ++n) v[bj][n] = acc[ai][bj][m][n] * rs;
        const int cl0 = 32 * wc + 8 * fq;
        if (kind == 0) {
          bf16_t* HQ = (bf16_t*)(ws + WS_G1 + G1_HQ); float* SSQQ = (float*)(ws + WS_SSQQ);
          float s = (ss4(v[0][0]) + ss4(v[0][1])) + (ss4(v[1][0]) + ss4(v[1][1]));
          s = red_fq(s);
          if (fq == 0) *(GAS float*)(SSQQ + (size_t)row * 4 + wc) = s;
#pragma unroll
          for (int bj = 0; bj < 2; ++bj) *(GAS u32x4*)(HQ + (size_t)row * 256 + 128 * bj + cl0) = pack8(v[bj][0], v[bj][1]);
        } else if (kind == 1) {
          float* HKV = (float*)(ws + WS_G1 + G1_HKV);
          *(GAS f32x4*)(HKV + (size_t)row * 160 + cl0) = v[0][0]; *(GAS f32x4*)(HKV + (size_t)row * 160 + cl0 + 4) = v[0][1];
          if (wc == 0) { *(GAS f32x4*)(HKV + (size_t)row * 160 + 128 + cl0) = v[1][0]; *(GAS f32x4*)(HKV + (size_t)row * 160 + 128 + cl0 + 4) = v[1][1]; }
        } else if (kind == 2 || kind == 3 || kind == 5 || kind == 8) {
          bf16_t* dst = kind == 5 ? (bf16_t*)(ws + WS_GB) + (size_t)row * 256 : kind == 8 ? (bf16_t*)(ws + WS_G1 + G1_GC) + (size_t)row * 256 : (bf16_t*)(ws + WS_R2 + R2_GA) + (size_t)row * 512 + (kind - 2) * 256;
#pragma unroll
          for (int bj = 0; bj < 2; ++bj) {
            f32x4 a = v[bj][0], b = v[bj][1];
#pragma unroll
            for (int q = 0; q < 4; ++q) { a[q] = siluf_(a[q]); b[q] = siluf_(b[q]); }
            *(GAS u32x4*)(dst + 128 * bj + cl0) = pack8(a, b);
          }
        } else if (kind == 4) {
          bf16_t* UB = (bf16_t*)(ws + WS_G1 + G1_UB);
#pragma unroll
          for (int bj = 0; bj < 2; ++bj) *(GAS u32x4*)(UB + (size_t)row * 256 + 128 * bj + cl0) = pack8(v[bj][0], v[bj][1]);
          float* o = nullptr;
          if (row < MP) { const int t = row & 8191; if (t >= 8177) o = out + O_PLP + (((size_t)layer * 8 + (row >> 13)) * 15 + (t - 8177)) * 256; }
          else { const int rsm = row - MP, t = rsm & 63; if (t >= 49) o = out + O_PLS + (((size_t)layer * 8 + (rsm >> 6)) * 15 + (t - 49)) * 256; }
          if (o) {
#pragma unroll
            for (int bj = 0; bj < 2; ++bj) { *(GAS f32x4*)(o + 128 * bj + cl0) = v[bj][0]; *(GAS f32x4*)(o + 128 * bj + cl0 + 4) = v[bj][1]; }
          }
        } else {
          float s = (ss4(v[0][0]) + ss4(v[0][1])) + (ss4(v[1][0]) + ss4(v[1][1]));
          s = red_fq(s);
          const float r2 = __builtin_amdgcn_rsqf(s * (1.0f / 64.0f) + EPSF) * (kind == 6 ? QSCALE_CA : 1.0f);
#pragma unroll
          for (int bj = 0; bj < 2; ++bj) {
            const int e0 = 32 * bj + 8 * fq;
            const f32x4 g0 = gq[bj][0], g1 = gq[bj][1];
            const f32x4 a = v[bj][0] * g0 * r2, b = v[bj][1] * g1 * r2;
            const u32x4 w = pack8(a, b);
            if (kind == 6) *(GAS u32x4*)((bf16_t*)(ws + WS_G1 + G1_QC) + (size_t)row * 256 + wc * 64 + e0) = w;
            else {
              if (row < MP) {
                *(GAS u32x4*)((bf16_t*)(ws + WS_G1 + G1_KC) + (size_t)row * 256 + wc * 64 + e0) = w;
                const int t = row & 8191;
                if (t >= 7680) { float* o = out + O_CKP + (((size_t)layer * 8 + (row >> 13)) * 512 + (t - 7680)) * 256 + wc * 64 + e0; *(GAS f32x4*)o = a; *(GAS f32x4*)(o + 4) = b; }
              } else {
                const int rsm = row - MP, b_ = rsm >> 6, t = rsm & 63;
                *(GAS u32x4*)((bf16_t*)(ws + WS_KCS) + (((size_t)layer * 8 + b_) * CAKS + 512 + t) * 256 + wc * 64 + e0) = w;
                float* o = out + O_CKS + (((size_t)layer * 8 + b_) * 64 + t) * 256 + wc * 64 + e0; *(GAS f32x4*)o = a; *(GAS f32x4*)(o + 4) = b;
              }
            }
          }
        }
        FENCE();
      }
  }
  DI void operator()(Acc& acc, const Unit& u, int wr, int wc, int fr, int fq) const {
    const int kind = u.kind;
    unsigned char* ws = P->ws; float* out = P->out; OPAQUE(ws); OPAQUE(out);
    const float* SSQX = (const float*)(ws + WS_SSQX);
    if (kind == 9) {
      const int j = u.pn;
      bf16_t* VCT = (bf16_t*)(ws + WS_G1 + G1_VCT); bf16_t* VCTSl = (bf16_t*)(ws + WS_VCTS) + (size_t)layer * 8 * 256 * CAKS;
#pragma unroll
      for (int bj = 0; bj < 2; ++bj) {
        const int tl = 128 * bj + 32 * wc + 8 * fq;
        const int tok = 256 * j + tl;
        float rs[8];
#pragma unroll
        for (int q = 0; q < 8; ++q) rs[q] = *(const GAS float*)(SSQX + (size_t)(tok + q) * 16 + fr);
#pragma unroll
        for (int q = 0; q < 8; ++q) { float t = rs[q]; t += swz_xor<1>(t); t += swz_xor<2>(t); t += swz_xor<4>(t); t += swz_xor<8>(t); rs[q] = __builtin_amdgcn_rsqf(t * (1.0f / 1024.0f) + EPSF); }
#pragma unroll
        for (int ai = 0; ai < 2; ++ai)
#pragma unroll
          for (int m = 0; m < 4; ++m) {
            const int hd = 128 * ai + 64 * wr + 16 * m + fr;
            f32x4 v0 = acc[ai][bj][m][0], v1 = acc[ai][bj][m][1];
#pragma unroll
            for (int q = 0; q < 4; ++q) { v0[q] *= rs[q]; v1[q] *= rs[4 + q]; }
            const u32x4 w = pack8(v0, v1);
            if (j < 256) {
              const int b = j >> 5, t = tok & 8191;
              *(GAS u32x4*)(VCT + ((size_t)(b * 256 + hd)) * 8192 + t) = w;
              if (t >= 7680) {
                float* o = out + O_CVP + (((size_t)layer * 8 + b) * 512 + (t - 7680)) * 256 + hd;
#pragma unroll
                for (int q = 0; q < 4; ++q) { *(GAS float*)(o + (size_t)q * 256) = v0[q]; *(GAS float*)(o + (size_t)(4 + q) * 256) = v1[q]; }
              }
            } else {
              const int ts = tok - MP, b = ts >> 6, t = ts & 63;
              *(GAS u32x4*)(VCTSl + ((size_t)(b * 256 + hd)) * CAKS + 512 + t) = w;
              float* o = out + O_CVS + (((size_t)layer * 8 + b) * 64 + t) * 256 + hd;
#pragma unroll
              for (int q = 0; q < 4; ++q) { *(GAS float*)(o + (size_t)q * 256) = v0[q]; *(GAS float*)(o + (size_t)(4 + q) * 256) = v1[q]; }
            }
            FENCE();
          }
      }
      return;
    }
    float rs8[8];
    rstd8(SSQX, u.pm * 256 + 64 * wr + fr, fq, 1.0f / 1024.0f, rs8);
    if (kind >= 10) {
      bf16_t* GMS = (bf16_t*)(ws + WS_GMS);
#pragma unroll
      for (int ai = 0; ai < 2; ++ai)
#pragma unroll
        for (int m = 0; m < 4; ++m) {
          const int rsm = (u.pm - 256) * 256 + 128 * ai + 64 * wr + 16 * m + fr;
#pragma unroll
          for (int bj = 0; bj < 2; ++bj) {
            f32x4 a = acc[ai][bj][m][0] * rs8[ai * 4 + m], b = acc[ai][bj][m][1] * rs8[ai * 4 + m];
#pragma unroll
            for (int q = 0; q < 4; ++q) { a[q] = sigmoidf_(a[q]); b[q] = sigmoidf_(b[q]); }
            *(GAS u32x4*)(GMS + (size_t)rsm * 3072 + (kind - 10) * 1024 + u.pn * 256 + 128 * bj + 32 * wc + 8 * fq) = pack8(a, b);
          }
          FENCE();
        }
      return;
    }
    switch (kind) {
      case 0: rows<0>(acc, u, wr, wc, fr, fq, ws, out, rs8); break;
      case 1: rows<1>(acc, u, wr, wc, fr, fq, ws, out, rs8); break;
      case 2: rows<2>(acc, u, wr, wc, fr, fq, ws, out, rs8); break;
      case 3: rows<3>(acc, u, wr, wc, fr, fq, ws, out, rs8); break;
      case 4: rows<4>(acc, u, wr, wc, fr, fq, ws, out, rs8); break;
      case 5: rows<5>(acc, u, wr, wc, fr, fq, ws, out, rs8); break;
      case 6: rows<6>(acc, u, wr, wc, fr, fq, ws, out, rs8); break;
      case 7: rows<7>(acc, u, wr, wc, fr, fq, ws, out, rs8); break;
      default: rows<8>(acc, u, wr, wc, fr, fq, ws, out, rs8); break;
    }
  }
};

struct SchedQ {
  const unsigned char* ws; int layer, G, vcu;
  DI bool next(int i, Unit& u) const {
    int L = i * G + vcu; if (L >= MT * 3 * DUP_Q) return false;
    L %= MT * 3;
    u.pm = L / 3; u.pn = L % 3; u.kind = u.pn; u.nt = 4;
    u.A = (const char*)(ws + WS_G1 + G1_HQ) + (size_t)u.pm * 256 * 512; u.B = (const char*)(ws + WS_W + (size_t)layer * WL_SIZE + WL_WUQ) + (size_t)u.pn * 256 * 512; return true;
  }
};
struct EpiQ {
  const Params* P; int layer;
  DI void operator()(Acc& acc, const Unit& u, int wr, int wc, int fr, int fq) const {
    unsigned char* ws = P->ws; OPAQUE(ws);
    const float* SSQQ = (const float*)(ws + WS_SSQQ); bf16_t* QP = (bf16_t*)(ws + WS_R2 + R2_QP);
    float rs8[8];
#pragma unroll
    for (int k = 0; k < 8; ++k) rs8[k] = *(const GAS float*)(SSQQ + (size_t)(u.pm * 256 + 128 * (k >> 2) + 64 * wr + 16 * (k & 3) + fr) * 4 + fq);
#pragma unroll
    for (int k = 0; k < 8; ++k) rs8[k] = __builtin_amdgcn_rsqf(red_fq(rs8[k]) * (1.0f / 256.0f) + EPSF);
#pragma unroll
    for (int ai = 0; ai < 2; ++ai)
#pragma unroll
      for (int m = 0; m < 4; ++m) {
        const int row = u.pm * 256 + 128 * ai + 64 * wr + 16 * m + fr;
        const float rs = rs8[ai * 4 + m];
        f32x4 v[2][2];
#pragma unroll
        for (int bj = 0; bj < 2; ++bj)
#pragma unroll
          for (int n = 0; n < 2; ++n) v[bj][n] = acc[ai][bj][m][n] * rs;
        if (u.kind < 2) {
          const float* qn_nope = GP(P->in[15]) + layer * 64;
          const int head = 4 * u.pn + wc;
          float s = (ss4(v[0][0]) + ss4(v[0][1])) + (ss4(v[1][0]) + ss4(v[1][1]));
          s = red_fq(s);
          const float r2 = __builtin_amdgcn_rsqf(s * (1.0f / 64.0f) + EPSF) * QSCALE_MLA;
#pragma unroll
          for (int bj = 0; bj < 2; ++bj) {
            const int e0 = 32 * bj + 8 * fq;
            const f32x4 g0 = *(const GAS f32x4*)(qn_nope + e0), g1 = *(const GAS f32x4*)(qn_nope + e0 + 4);
            *(GAS u32x4*)(QP + (size_t)row * 768 + head * 96 + e0) = pack8(v[bj][0] * g0 * r2, v[bj][1] * g1 * r2);
          }
        } else {
          const float* qn_rope = GP(P->in[16]) + layer * 32; const float* CS = (const float*)(ws + WS_CS);
          const int pos = row < MP ? (row & 8191) : PAST + ((row - MP) & 63);
          const int i0 = 8 * (fq & 1);
          const f32x4 c0 = *(const GAS f32x4*)(CS + pos * 32 + i0), c1 = *(const GAS f32x4*)(CS + pos * 32 + i0 + 4);
          const f32x4 s0 = *(const GAS f32x4*)(CS + pos * 32 + 16 + i0), s1 = *(const GAS f32x4*)(CS + pos * 32 + 16 + i0 + 4);
          const f32x4 g0 = *(const GAS f32x4*)(qn_rope + 8 * fq), g1 = *(const GAS f32x4*)(qn_rope + 8 * fq + 4);
          const float sg = fq < 2 ? -1.0f : 1.0f;
#pragma unroll
          for (int bj = 0; bj < 2; ++bj) {
            const int head = 2 * wc + bj;
            float s = ss4(v[bj][0]) + ss4(v[bj][1]);
            s = red_fq(s);
            const float r2 = __builtin_amdgcn_rsqf(s * (1.0f / 32.0f) + EPSF);
            f32x4 y0 = v[bj][0] * g0 * r2, y1 = v[bj][1] * g1 * r2, o0, o1;
#pragma unroll
            for (int q = 0; q < 4; ++q) {
              const float p0 = get_xor32(y0[q], fq >= 2), p1 = get_xor32(y1[q], fq >= 2);
              o0[q] = (y0[q] * c0[q] + sg * p0 * s0[q]) * QSCALE_MLA;
              o1[q] = (y1[q] * c1[q] + sg * p1 * s1[q]) * QSCALE_MLA;
            }
            *(GAS u32x4*)(QP + (size_t)row * 768 + head * 96 + 64 + 8 * fq) = pack8(o0, o1);
          }
        }
        FENCE();
      }
  }
};

DI void post_kv(const Frame& F) {
  const int tid = otid(), lane = tid & 63;
  const int gw = obid() * 8 + (tid >> 6), nw = ogdim() * 8;
  const GAS float* HKV = (const GAS float*)F.g1(G1_HKV); const GAS float* CS = (const GAS float*)(F.W() + WS_CS);
  const GAS float* kvn = (const GAS float*)F.lin(13, 128); const GAS float* knr = (const GAS float*)F.lin(18, 32);
  GAS bf16_t* CKVB = (GAS bf16_t*)(F.W() + WS_CKVB); GAS bf16_t* KRB = (GAS bf16_t*)(F.W() + WS_KRB);
  GAS float* out = (GAS float*)F.O();
  const f32x2 g = *(const GAS f32x2*)(kvn + 2 * lane);
  const float gr = knr[lane & 31];
  for (int row0 = gw; row0 < MROWS; row0 += 4 * nw) {
    f32x2 v[4]; float kr[4], csv[4], snv[4];
#pragma unroll
    for (int k = 0; k < 4; ++k) { const int row = row0 + k * nw; const bool ok = row < MROWS; const size_t rr = ok ? row : 0;
      const int pos_ = rr < (size_t)MP ? (int)(rr & 8191) : PAST + (int)((rr - MP) & 63);
      v[k] = *(const GAS f32x2*)(HKV + rr * 160 + 2 * lane); kr[k] = HKV[rr * 160 + 128 + (lane & 31)];
      csv[k] = CS[pos_ * 32 + (lane & 15)]; snv[k] = CS[pos_ * 32 + 16 + (lane & 15)]; }
#pragma unroll
    for (int k = 0; k < 4; ++k) kr[k] = lane < 32 ? kr[k] : 0.f;
#pragma unroll
    for (int k = 0; k < 4; ++k) {
      const int row = row0 + k * nw; if (row >= MROWS) break;
      const float sc = wave_sum(v[k][0] * v[k][0] + v[k][1] * v[k][1]);
      const float sr = wave_sum(kr[k] * kr[k]);
      const float rc = __builtin_amdgcn_rsqf(sc * (1.0f / 128.0f) + EPSF), rr = __builtin_amdgcn_rsqf(sr * (1.0f / 32.0f) + EPSF);
      const f32x2 c = {v[k][0] * rc * g[0], v[k][1] * rc * g[1]};
      int pos; size_t R; GAS float* oc; GAS float* ok;
      if (row < MP) { pos = row & 8191; R = row; oc = out + O_CKVP + ((size_t)F.layer * MP + row) * 128; ok = out + O_KRP + ((size_t)F.layer * MP + row) * 32; }
      else { const int rsm = row - MP, b = rsm >> 6, t = rsm & 63; pos = PAST + t; R = (size_t)MP + (size_t)b * TKS + PAST + t;
             oc = out + O_CKVS + ((size_t)F.layer * MS + rsm) * 128; ok = out + O_KRS + ((size_t)F.layer * MS + rsm) * 32; }
      *(GAS f32x2*)(oc + 2 * lane) = c;
      *(GAS unsigned*)(CKVB + R * 128 + 2 * lane) = pk2(c[0], c[1]);
      const float y = kr[k] * rr * gr;
      const float p = swz_xor<16>(y);
      const int idx = lane & 15;
      const float cs = csv[k], sn = snv[k]; (void)idx; (void)pos;
      const float o = y * cs + ((lane & 16) ? p : -p) * sn;
      if (lane < 32) { ok[lane] = o; KRB[R * 32 + lane] = (bf16_t)(pk2(o, 0.f) & 0xffffu); }
    }
  }
}

DI void pooled_rows(const Frame& F) {
  const int tid = otid(), lane = tid & 63;
  const int gw = obid() * 8 + (tid >> 6), nw = ogdim() * 8;
  const GAS bf16_t* UB = (const GAS bf16_t*)F.g1(G1_UB); GAS bf16_t* PO = (GAS bf16_t*)(F.W() + WS_POOLED);
  const GAS float* hist = (const GAS float*)F.lin(6, 8 * 15 * 256);
  const int w = 2 << (lane >> 4), c = 4 * lane;
  for (int row = gw; row < MROWS; row += nw) {
    f32x4 s = {0.f, 0.f, 0.f, 0.f}, u0 = s; float cnt;
    if (row < MP) {
      const int t = row & 8191; cnt = (float)(t + 1 < w ? t + 1 : w);
      u32x2 x[16];
#pragma unroll
      for (int j = 0; j < 16; ++j) { const bool ok = j < w && j <= t; x[j] = *(const GAS u32x2*)(UB + (size_t)(ok ? row - j : row) * 256 + c); }
#pragma unroll
      for (int j = 0; j < 16; ++j) {
        const bool ok = j < w && j <= t;
        const f32x4 f = {bflo(x[j].x), bfhi(x[j].x), bflo(x[j].y), bfhi(x[j].y)};
        if (j == 0) u0 = f;
        const float mk = ok ? 1.0f : 0.0f;
        s += f * mk;
      }
    } else {
      const int rsm = row - MP, b = rsm >> 6, t = rsm & 63; cnt = (float)w;
      for (int j = 0; j < 16; ++j) if (j < w) {
        f32x4 f;
        if (j <= t) { const u32x2 x = *(const GAS u32x2*)(UB + (size_t)(row - j) * 256 + c); f = (f32x4){bflo(x.x), bfhi(x.x), bflo(x.y), bfhi(x.y)}; }
        else f = *(const GAS f32x4*)(hist + ((size_t)b * 15 + (15 + t - j)) * 256 + c);
        s += f; if (j == 0) u0 = f; }
    }
    const float ic = 1.0f / cnt;
    const f32x4 p = s * ic - u0;
    u32x2 wv; wv.x = pk2(p[0], p[1]); wv.y = pk2(p[2], p[3]);
    *(GAS u32x2*)(PO + (size_t)row * 256 + c) = wv;
  }
}

template <int DQK, bool BIAS, bool PARTIAL>
DI void attn_unit(LAS unsigned char* lds, const bf16_t* Qw, int qpitch, const bf16_t* Kb, int kpitch, const bf16_t* Vt, int vpitch,
                  int t_begin, int t_end, int w_lo, int w_hi, bool active,
                  const float* btab_g, int kpos0, int qpos_w,
                  const bf16_t* gate, int gpitch, bf16_t* outp  , float* part  ) {
  constexpr int KS = DQK / 16, KPB = DQK * 2 + 16, KTILE = 64 * KPB, VPB = 136, VTILE = 64 * VPB, SEG = DQK / 8, NPK = 64 * SEG;
  constexpr int OFF_K = 0, OFF_V = 2 * KTILE, OFF_BT = OFF_V + 2 * VTILE;
  const int tid = otid(), lane = tid & 63, r = lane & 31, h = lane >> 5;
  LAS float* bt = (LAS float*)(lds + OFF_BT);
  const int p1 = (tid + 512) < NPK ? tid + 512 : tid;
  const int kr0 = tid / SEG, ks0 = tid % SEG, kr1 = p1 / SEG, ks1 = p1 % SEG;
  const int vd = tid >> 3, vs = tid & 7;
  const bf16_t* kp0 = Kb + (size_t)kr0 * kpitch + 8 * ks0; const bf16_t* kp1 = Kb + (size_t)kr1 * kpitch + 8 * ks1; const bf16_t* vp0 = Vt + (size_t)vd * vpitch + 8 * vs;
  const int lk0 = OFF_K + kr0 * KPB + ks0 * 16, lk1 = OFF_K + kr1 * KPB + ks1 * 16, lv0 = OFF_V + vd * VPB + vs * 16;
  u32x4 ak0, ak1 = {0, 0, 0, 0}, av, bk0, bk1 = {0, 0, 0, 0}, bv;
#define AT_GLOAD(K0, K1, V, t) do { const int tt_ = (t) < t_end ? (t) : t_end - 1; K0 = *(const GAS u32x4*)(kp0 + (size_t)tt_ * 64 * kpitch); if (NPK > 512) K1 = *(const GAS u32x4*)(kp1 + (size_t)tt_ * 64 * kpitch); V = *(const GAS u32x4*)(vp0 + 64 * tt_); } while (0)
#define AT_LSTORE(K0, K1, V, buf) do { *(LAS u32x4*)(lds + (buf) * KTILE + lk0) = K0; if (NPK > 512) *(LAS u32x4*)(lds + (buf) * KTILE + lk1) = K1; \
    *(LAS u32x2*)(lds + (buf) * VTILE + lv0) = (u32x2){V.x, V.y}; *(LAS u32x2*)(lds + (buf) * VTILE + lv0 + 8) = (u32x2){V.z, V.w}; } while (0)
  if ((__builtin_amdgcn_readfirstlane(tid >> 6) >> 2) != 0) __builtin_amdgcn_s_setprio(1);
  AT_GLOAD(ak0, ak1, av, t_begin);
  AT_GLOAD(bk0, bk1, bv, t_begin + 1);
  if (BIAS) { if (tid < 257) bt[tid] = ((const GAS float*)btab_g)[tid] * LOG2E; }
  bf16x8 qr[KS];
  if (active) {
#pragma unroll
    for (int s = 0; s < KS; ++s) qr[s] = *(const GAS bf16x8*)(Qw + (size_t)r * qpitch + 16 * s + 8 * h);
  } else {
#pragma unroll
    for (int s = 0; s < KS; ++s) qr[s] = (bf16x8){0, 0, 0, 0, 0, 0, 0, 0};
  }
  AT_LSTORE(ak0, ak1, av, 0);
  __syncthreads();
  float mrun = 0.0f;
  const f32x16 z16 = {0.f, 0.f, 0.f, 0.f, 0.f, 0.f, 0.f, 0.f, 0.f, 0.f, 0.f, 0.f, 0.f, 0.f, 0.f, 0.f};
  f32x16 o0 = z16, o1 = z16, negm = z16 - mrun;
  float lq0 = 0.f, lq1 = 0.f;
  auto compute = [&](int t, int buf) {
    const LAS unsigned char* kb = lds + OFF_K + buf * KTILE + r * KPB + h * 16;
    const LAS unsigned char* vb = lds + OFF_V + buf * VTILE + r * VPB + h * 8;
    f32x16 s0, s1;
#pragma unroll
    for (int hf = 0; hf < 2; ++hf) {
      bf16x8 kf[KS];
#pragma unroll
      for (int s = 0; s < KS / 2; ++s) { kf[2 * s] = *(const LAS bf16x8*)(kb + (hf * (KS / 2) + s) * 32); kf[2 * s + 1] = *(const LAS bf16x8*)(kb + 32 * KPB + (hf * (KS / 2) + s) * 32); }
      __builtin_amdgcn_sched_barrier(0);
#pragma unroll
      for (int s = 0; s < KS / 2; ++s) {
        const int ss = hf * (KS / 2) + s;
        if (ss == 0) { s0 = __builtin_amdgcn_mfma_f32_32x32x16_bf16(kf[0], qr[0], negm, 0, 0, 0); s1 = __builtin_amdgcn_mfma_f32_32x32x16_bf16(kf[1], qr[0], negm, 0, 0, 0); }
        else { s0 = __builtin_amdgcn_mfma_f32_32x32x16_bf16(kf[2 * s], qr[ss], s0, 0, 0, 0); s1 = __builtin_amdgcn_mfma_f32_32x32x16_bf16(kf[2 * s + 1], qr[ss], s1, 0, 0, 0); }
      }
    }
    u32x2 vf[16];
#pragma unroll
    for (int s2 = 0; s2 < 4; ++s2) {
      const int kvo = (32 * (s2 >> 1) + 16 * (s2 & 1)) * 2;
      vf[4 * s2] = *(const LAS u32x2*)(vb + kvo); vf[4 * s2 + 1] = *(const LAS u32x2*)(vb + kvo + 16);
      vf[4 * s2 + 2] = *(const LAS u32x2*)(vb + 32 * VPB + kvo); vf[4 * s2 + 3] = *(const LAS u32x2*)(vb + 32 * VPB + kvo + 16);
    }
    __builtin_amdgcn_sched_barrier(0);
    if (BIAS) {
      const int dlt = kpos0 + 64 * t - (qpos_w + r) + 4 * h;
      if (kpos0 + 64 * t + 63 - qpos_w <= -128) {
        const float bc = bt[0];
        s0 = s0 + bc; s1 = s1 + bc;
      } else {
#pragma unroll
        for (int i = 0; i < 16; ++i) {
          const int d0 = dlt + (i & 3) + 8 * (i >> 2), d1 = d0 + 32;
          const int i0 = (d0 < -128 ? -128 : (d0 > 128 ? 128 : d0)) + 128, i1 = (d1 < -128 ? -128 : (d1 > 128 ? 128 : d1)) + 128;
          s0[i] += bt[i0]; s1[i] += bt[i1];
        }
      }
    }
    float mx = fmaxf(fmaxf(s0[0], s0[1]), s1[0]), my = fmaxf(fmaxf(s0[2], s0[3]), s1[1]);
    mx = fmaxf(fmaxf(mx, s1[2]), s1[3]);
#pragma unroll
    for (int i = 4; i < 16; i += 4) { mx = fmaxf(fmaxf(mx, s0[i]), s0[i + 1]); my = fmaxf(fmaxf(my, s0[i + 2]), s0[i + 3]); mx = fmaxf(fmaxf(mx, s1[i]), s1[i + 1]); my = fmaxf(fmaxf(my, s1[i + 2]), s1[i + 3]); }
    mx = max_xor32(fmaxf(mx, my));
    if (__builtin_amdgcn_ballot_w64(mx > 0.0f) != 0ull) {
      const float dl = fmaxf(mx, 0.0f);
      const float alpha = __builtin_amdgcn_exp2f(-dl);
      mrun += dl;
      o0 = o0 * alpha; o1 = o1 * alpha; lq0 *= alpha; lq1 *= alpha;
      s0 = s0 - dl; s1 = s1 - dl; negm = z16 - mrun;
    }
#pragma unroll
    for (int s2 = 0; s2 < 4; ++s2) {
      const int b8 = 8 * (s2 & 1);
      float e[8];
#pragma unroll
      for (int i = 0; i < 8; ++i) e[i] = __builtin_amdgcn_exp2f(s2 < 2 ? s0[b8 + i] : s1[b8 + i]);
#pragma unroll
      for (int i = 0; i < 8; ++i) { if (i & 1) asm("v_add_f32 %0, %0, %1" : "+v"(lq1) : "v"(e[i])); else asm("v_add_f32 %0, %0, %1" : "+v"(lq0) : "v"(e[i])); }
      u32x4 w; w.x = pk2(e[0], e[1]); w.y = pk2(e[2], e[3]); w.z = pk2(e[4], e[5]); w.w = pk2(e[6], e[7]);
      const bf16x8 pbs = __builtin_bit_cast(bf16x8, w);
      const bf16x8 va0 = __builtin_bit_cast(bf16x8, (u32x4){vf[4 * s2].x, vf[4 * s2].y, vf[4 * s2 + 1].x, vf[4 * s2 + 1].y});
      const bf16x8 va1 = __builtin_bit_cast(bf16x8, (u32x4){vf[4 * s2 + 2].x, vf[4 * s2 + 2].y, vf[4 * s2 + 3].x, vf[4 * s2 + 3].y});
      __builtin_amdgcn_sched_barrier(0);
      o0 = __builtin_amdgcn_mfma_f32_32x32x16_bf16(va0, pbs, o0, 0, 0, 0);
      o1 = __builtin_amdgcn_mfma_f32_32x32x16_bf16(va1, pbs, o1, 0, 0, 0);
      __builtin_amdgcn_sched_barrier(0);
    }
  };
  for (int t = t_begin; t < t_end; t += 2) {
    AT_GLOAD(ak0, ak1, av, t + 2);
    if (active && t >= w_lo && t <= w_hi) compute(t, 0);
    AT_LSTORE(bk0, bk1, bv, 1);
    __syncthreads();
    AT_GLOAD(bk0, bk1, bv, t + 3);
    if (active && t + 1 >= w_lo && t + 1 <= w_hi && t + 1 < t_end) compute(t + 1, 1);
    AT_LSTORE(ak0, ak1, av, 0);
    __syncthreads();
  }
#undef AT_GLOAD
#undef AT_LSTORE
  __builtin_amdgcn_s_setprio(0);
  if (active) {
    const float ll = lq0 + lq1;
    const float lt = sum_xor32(ll);
    if (PARTIAL) {
      float* pp = part + (size_t)r * 66;
      if (h == 0) { pp[0] = mrun; pp[1] = lt; }
#pragma unroll
      for (int db = 0; db < 2; ++db)
#pragma unroll
        for (int g4 = 0; g4 < 4; ++g4) {
          const int d0 = 32 * db + 8 * g4 + 4 * h;
          f32x2 x0 = {db ? o1[4 * g4] : o0[4 * g4], db ? o1[4 * g4 + 1] : o0[4 * g4 + 1]}, x1 = {db ? o1[4 * g4 + 2] : o0[4 * g4 + 2], db ? o1[4 * g4 + 3] : o0[4 * g4 + 3]};
          *(GAS f32x2*)(pp + 2 + d0) = x0; *(GAS f32x2*)(pp + 4 + d0) = x1;
        }
    } else {
      const float il = 1.0f / lt;
      const bf16_t* gp = gate + (size_t)r * gpitch; bf16_t* op = outp + (size_t)r * 1024;
      u32x2 gg8[8];
#pragma unroll
      for (int k = 0; k < 8; ++k) gg8[k] = *(const GAS u32x2*)(gp + 32 * (k >> 2) + 8 * (k & 3) + 4 * h);
#pragma unroll
      for (int db = 0; db < 2; ++db)
#pragma unroll
        for (int g4 = 0; g4 < 4; ++g4) {
          const int d0 = 32 * db + 8 * g4 + 4 * h;
          const u32x2 gg = gg8[db * 4 + g4];
          const float a = (db ? o1[4 * g4] : o0[4 * g4]) * il * bflo(gg.x), b = (db ? o1[4 * g4 + 1] : o0[4 * g4 + 1]) * il * bfhi(gg.x);
          const float c = (db ? o1[4 * g4 + 2] : o0[4 * g4 + 2]) * il * bflo(gg.y), d = (db ? o1[4 * g4 + 3] : o0[4 * g4 + 3]) * il * bfhi(gg.y);
          u32x2 w; w.x = pk2(a, b); w.y = pk2(c, d);
          *(GAS u32x2*)(op + d0) = w;
        }
    }
  }
}

DI void ca_phase(const Frame& F, LAS unsigned char* lds) {
  const int wid = __builtin_amdgcn_readfirstlane(otid() >> 6);
  const bf16_t* QC = (const bf16_t*)F.g1(G1_QC); const bf16_t* KC = (const bf16_t*)F.g1(G1_KC); const bf16_t* VCT = (const bf16_t*)F.g1(G1_VCT);
  const bf16_t* GC = (const bf16_t*)F.g1(G1_GC); bf16_t* OC = (bf16_t*)(F.W() + WS_OCAT);
  const bf16_t* KCSl = (const bf16_t*)(F.W() + WS_KCS) + (size_t)F.layer * 8 * CAKS * 256;
  const bf16_t* VCTSl = (const bf16_t*)(F.W() + WS_VCTS) + (size_t)F.layer * 8 * 256 * CAKS;
  const float* rel = F.lin(25, 4 * 257);
  const int NU = 8 * 4 * 32 + 32;
  for (int it = 0;; ++it) {
    int L = it * F.G + F.vcu; if (L >= NU * DUP_CA) break;
    L %= NU;
    if (L < 1024) {
      const int g = 31 - (L >> 5), bh = L & 31, b = bh >> 2, hh = bh & 3;
      const int c = 4 * g + (wid >> 1);
      const size_t row0 = (size_t)b * 8192 + 256 * g + 32 * wid;
      const int tb = 4 * g - 8 < 0 ? 0 : 4 * g - 8;
      attn_unit<64, true, false>(lds, QC + row0 * 256 + hh * 64, 256, KC + (size_t)b * 8192 * 256 + hh * 64, 256, VCT + ((size_t)b * 256 + hh * 64) * 8192, 8192,
                          tb, 4 * g + 4, c - 8 < 0 ? 0 : c - 8, c, true, rel + hh * 257, 0, 256 * g + 32 * wid,
                          GC + row0 * 256 + hh * 64, 256, OC + row0 * 1024 + 768 + hh * 64, nullptr);
    } else {
      const int bh = L - 1024, b = bh >> 2, hh = bh & 3;
      const size_t row0 = (size_t)MP + b * 64 + 32 * (wid & 1);
      attn_unit<64, true, false>(lds, QC + row0 * 256 + hh * 64, 256, KCSl + (size_t)b * CAKS * 256 + hh * 64, 256, VCTSl + ((size_t)b * 256 + hh * 64) * CAKS, CAKS,
                          0, 9, 0, 8, wid < 2, rel + hh * 257, PAST - 512, PAST + 32 * (wid & 1),
                          GC + row0 * 256 + hh * 64, 256, OC + row0 * 1024 + 768 + hh * 64, nullptr);
    }
  }
}

DI void mla_phase(const Frame& F, LAS unsigned char* lds) {
  const int wid = __builtin_amdgcn_readfirstlane(otid() >> 6);
  const bf16_t* QP = (const bf16_t*)F.r2(R2_QP); const bf16_t* GA = (const bf16_t*)F.r2(R2_GA);
  const bf16_t* KP = (const bf16_t*)F.g1(G1_KP); const bf16_t* KPS = (const bf16_t*)F.g1(G1_KPS);
  const bf16_t* VT = (const bf16_t*)F.g1(G1_VT); const bf16_t* VTS = (const bf16_t*)F.g1(G1_VTS);
  bf16_t* OC = (bf16_t*)(F.W() + WS_OCAT); float* PART = (float*)(F.W() + WS_PART);
  const int NU = 2048 + 256;
  for (int it = 0;; ++it) {
    int L;
    if (F.G == 256) {
      const int x = F.vcu >> 5, jj = F.vcu & 31;
      if (it < 8) { const int bh = x * 8 + it, qb = (it & 1) ? 31 - jj : jj; L = -1 - (bh * 32 + qb); }
      else if (it == 8) L = 2048 + F.vcu; else break;
    } else { L = it * F.G + F.vcu; if (L >= NU) break; if (L < 2048) { const int qb = 31 - (L >> 6), bh = L & 63; L = -1 - (bh * 32 + qb); } }
    if (L < 0) {
      const int code = -1 - L, bh = code >> 5, qb = code & 31, b = bh >> 3, hh = bh & 7;
      const size_t row0 = (size_t)b * 8192 + 256 * qb + 32 * wid;
      attn_unit<96, false, false>(lds, QP + row0 * 768 + hh * 96, 768, KP + (size_t)bh * 8192 * 96, 96, VT + ((size_t)b * 512 + hh * 64) * 8192, 8192,
                                  0, 4 * qb + 4, 0, 4 * qb + (wid >> 1), true, nullptr, 0, 0,
                                  GA + row0 * 512 + hh * 64, 512, OC + row0 * 1024 + hh * 64, nullptr);
    } else {
      const int su = L - 2048, bh = su >> 2, qt = su & 3, b = bh >> 3, hh = bh & 7;
      const size_t row0 = (size_t)MP + b * 64 + 32 * (wid & 1);
      const int tb = qt * 17, te = tb + 17 > 65 ? 65 : tb + 17;
      attn_unit<96, false, true>(lds, QP + row0 * 768 + hh * 96, 768, KPS + (size_t)bh * TKS * 96, 96, VTS + ((size_t)b * 512 + hh * 64) * TKS, TKS,
                                 tb, te, tb, te - 1, wid < 2, nullptr, 0, 0,
                                 nullptr, 0, nullptr, PART + ((size_t)su * 64 + 32 * (wid & 1)) * 66);
    }
  }
}
DI void mla_combine(const Frame& F) {
  const int tid = otid(), lane = tid & 63;
  const int gw = obid() * 8 + (tid >> 6), nw = ogdim() * 8;
  const float* PART = (const float*)(F.W() + WS_PART); const bf16_t* GA = (const bf16_t*)F.r2(R2_GA); bf16_t* OC = (bf16_t*)(F.W() + WS_OCAT);
  for (int item = gw; item < 64 * 64; item += nw) {
    const int bh = item >> 6, rr = item & 63, b = bh >> 3, hh = bh & 7;
    float m[4], l[4], o[4];
#pragma unroll
    for (int q = 0; q < 4; ++q) { const float* pp = PART + ((size_t)(bh * 4 + q) * 64 + rr) * 66; m[q] = pp[0]; l[q] = pp[1]; o[q] = pp[2 + lane]; }
    const float M = fmaxf(fmaxf(m[0], m[1]), fmaxf(m[2], m[3]));
    float O = 0.f, Lt = 0.f;
#pragma unroll
    for (int q = 0; q < 4; ++q) { const float w = __builtin_amdgcn_exp2f(m[q] - M); O += w * o[q]; Lt += w * l[q]; }
    const size_t row = (size_t)MP + b * 64 + rr;
    const float g = __uint_as_float((unsigned)GA[row * 512 + hh * 64 + lane] << 16);
    OC[row * 1024 + hh * 64 + lane] = (bf16_t)(pk2(O / Lt * g, 0.f) & 0xffffu);
  }
}

struct SchedKV {
  const unsigned char* ws; int layer, G, vcu;
  DI bool next(int i, Unit& u) const {
    int L = i * G + vcu; if (L >= KVT * 4 * DUP_KV) return false;
    L %= KVT * 4;
    const int j = L >> 2, k = L & 3; u.nt = 2;
    const char* CKVB = (const char*)(ws + WS_CKVB); const char* WL = (const char*)(ws + WS_W + (size_t)layer * WL_SIZE);
    if (k < 2) { u.A = CKVB + (size_t)j * 256 * 256; u.B = WL + WL_WUK + (size_t)k * 256 * 256; u.pm = j; u.pn = k; u.kind = 0; }
    else { u.A = WL + WL_WUV + (size_t)(k - 2) * 256 * 256; u.B = CKVB + (size_t)j * 256 * 256; u.pm = k - 2; u.pn = j; u.kind = 1; }
    return true;
  }
};
struct EpiKV {
  const Params* P; int layer;
  DI void operator()(Acc& acc, const Unit& u, int wr, int wc, int fr, int fq) const {
    unsigned char* ws = P->ws; OPAQUE(ws);
    if (u.kind == 0) {
      const float* kn_nope = GP(P->in[17]) + layer * 64; const bf16_t* KRB = (const bf16_t*)(ws + WS_KRB);
      bf16_t* KP = (bf16_t*)(ws + WS_G1 + G1_KP); bf16_t* KPS = (bf16_t*)(ws + WS_G1 + G1_KPS);
      const int head = 4 * u.pn + wc;
      f32x4 gk[2][2];
#pragma unroll
      for (int bj = 0; bj < 2; ++bj) { gk[bj][0] = *(const GAS f32x4*)(kn_nope + 32 * bj + 8 * fq); gk[bj][1] = *(const GAS f32x4*)(kn_nope + 32 * bj + 8 * fq + 4); }
#pragma unroll
      for (int ai = 0; ai < 2; ++ai) {
        u32x4 kr8[8];
#pragma unroll
        for (int k = 0; k < 4; ++k) kr8[ai * 4 + k] = *(const GAS u32x4*)(KRB + (size_t)(u.pm * 256 + 128 * ai + 64 * wr + 16 * k + fr) * 32 + 8 * fq);
#pragma unroll
        for (int m = 0; m < 4; ++m) {
          const int R = u.pm * 256 + 128 * ai + 64 * wr + 16 * m + fr;
          bf16_t* dst;
          if (R < MP) dst = KP + ((size_t)((R >> 13) * 8 + head) * 8192 + (R & 8191)) * 96;
          else { const int Rs = R - MP, b = Rs / TKS, t = Rs - b * TKS; dst = KPS + ((size_t)(b * 8 + head) * TKS + t) * 96; }
          float s = (ss4(acc[ai][0][m][0]) + ss4(acc[ai][0][m][1])) + (ss4(acc[ai][1][m][0]) + ss4(acc[ai][1][m][1]));
          s = red_fq(s);
          const float r2 = __builtin_amdgcn_rsqf(s * (1.0f / 64.0f) + EPSF);
#pragma unroll
          for (int bj = 0; bj < 2; ++bj) {
            const int e0 = 32 * bj + 8 * fq;
            *(GAS u32x4*)(dst + e0) = pack8(acc[ai][bj][m][0] * gk[bj][0] * r2, acc[ai][bj][m][1] * gk[bj][1] * r2);
          }
          *(GAS u32x4*)(dst + 64 + 8 * fq) = kr8[ai * 4 + m];
        }
        FENCE();
      }
    } else {
      bf16_t* VT = (bf16_t*)(ws + WS_G1 + G1_VT); bf16_t* VTS = (bf16_t*)(ws + WS_G1 + G1_VTS);
      const int j = u.pn;
#pragma unroll
      for (int bj = 0; bj < 2; ++bj) {
        const int R = 256 * j + 128 * bj + 32 * wc + 8 * fq;
        bf16_t* base; size_t pitch;
        if (R < MP) { base = VT + (size_t)(R >> 13) * 512 * 8192 + (R & 8191); pitch = 8192; }
        else { const int Rs = R - MP, b = Rs / TKS, t = Rs - b * TKS; base = VTS + (size_t)b * 512 * TKS + t; pitch = TKS; }
#pragma unroll
        for (int ai = 0; ai < 2; ++ai)
#pragma unroll
          for (int m = 0; m < 4; ++m) {
            const int hd = u.pm * 256 + 128 * ai + 64 * wr + 16 * m + fr;
            *(GAS u32x4*)(base + (size_t)hd * pitch) = pack8(acc[ai][bj][m][0], acc[ai][bj][m][1]);
          }
      }
    }
  }
};
template <size_t OFFA, size_t OFFB_L, int LDA, int LDB, int KT, int NTC>
struct SchedRows {
  const unsigned char* ws; int layer, G, vcu;
  DI bool next(int i, Unit& u) const {
    const int L = i * G + vcu; if (L >= MT * NTC) return false;
    u.pm = L / NTC; u.pn = L % NTC; u.kind = 0; u.nt = KT;
    u.A = (const char*)(ws + OFFA) + (size_t)u.pm * 256 * LDA; u.B = (const char*)(ws + WS_W + (size_t)layer * WL_SIZE + OFFB_L) + (size_t)u.pn * 256 * LDB; return true;
  }
};
struct EpiPool {
  const Params* P;
  DI void operator()(Acc& acc, const Unit& u, int wr, int wc, int fr, int fq) const {
    unsigned char* ws = P->ws; OPAQUE(ws);
    const bf16_t* GB = (const bf16_t*)(ws + WS_GB); bf16_t* OC = (bf16_t*)(ws + WS_OCAT);
#pragma unroll
    for (int ai = 0; ai < 2; ++ai) {
      u32x4 g16[4][2];
#pragma unroll
      for (int m = 0; m < 4; ++m)
#pragma unroll
        for (int bj = 0; bj < 2; ++bj) g16[m][bj] = *(const GAS u32x4*)(GB + (size_t)(u.pm * 256 + 128 * ai + 64 * wr + 16 * m + fr) * 256 + 128 * bj + 32 * wc + 8 * fq);
#pragma unroll
      for (int m = 0; m < 4; ++m) {
        const int row = u.pm * 256 + 128 * ai + 64 * wr + 16 * m + fr;
#pragma unroll
        for (int bj = 0; bj < 2; ++bj) {
          const int c0 = 128 * bj + 32 * wc + 8 * fq;
          const u32x4 g = g16[m][bj];
          f32x4 a = acc[ai][bj][m][0], b = acc[ai][bj][m][1];
          a[0] *= bflo(g.x); a[1] *= bfhi(g.x); a[2] *= bflo(g.y); a[3] *= bfhi(g.y);
          b[0] *= bflo(g.z); b[1] *= bfhi(g.z); b[2] *= bflo(g.w); b[3] *= bfhi(g.w);
          *(GAS u32x4*)(OC + (size_t)row * 1024 + 512 + c0) = pack8(a, b);
        }
      }
      FENCE();
    }
  }
};

struct SchedMerge {
  const unsigned char* ws; int layer, G, vcu;
  DI bool next(int i, Unit& u) const {
    const int nfull = vcu < 1024 ? (1024 - vcu + G - 1) / G : 0;
    int ti, sub;
    if (i < 6 * nfull) { ti = i / 6; sub = i - ti * 6; }
    else { const int j = i - 6 * nfull, tj = j / 3; ti = nfull + tj; sub = 2 * (j - tj * 3) + 1; }
    const int L = ti * G + vcu; if (L >= MT * 4) return false;
    const int pm = L >> 2, pn = L & 3, s = sub >> 1;
    u.pm = pm; u.pn = pn; u.kind = sub;
    const char* WL = (const char*)(ws + WS_W + (size_t)layer * WL_SIZE);
    if ((sub & 1) == 0) { u.A = (const char*)(ws + WS_XB) + (size_t)pm * 256 * 2048; u.B = WL + WL_WIN + (size_t)(2560 + s * 1024 + pn * 256) * 2048; u.nt = 16; }
    else { const int koff = s == 0 ? 0 : (s == 1 ? 512 : 768); u.A = (const char*)(ws + WS_OCAT) + (size_t)pm * 256 * 2048 + koff * 2; u.B = WL + WL_WCAT + (size_t)pn * 256 * 2048 + koff * 2; u.nt = s == 0 ? 8 : 4; }
    return true;
  }
};
struct EpiMerge {
  const Params* P;
  DI void operator()(Acc& acc, const Unit& u, int wr, int wc, int fr, int fq) const {
    const int tid = otid();
    unsigned char* ws = P->ws; OPAQUE(ws);
    GAS u32x4* gs = (GAS u32x4*)(ws + WS_R2 + (size_t)obid() * P6_SCR_PER_WG); GAS u32x4* ms = gs + 16 * 512;
    if ((u.kind & 1) == 0) {
      const float* SSQX = (const float*)(ws + WS_SSQX);
      float rs8[8];
      rstd8(SSQX, u.pm * 256 + 64 * wr + fr, fq, 1.0f / 1024.0f, rs8);
#pragma unroll
      for (int ai = 0; ai < 2; ++ai)
#pragma unroll
        for (int m = 0; m < 4; ++m) {
          const float rs = rs8[ai * 4 + m];
#pragma unroll
          for (int bj = 0; bj < 2; ++bj) {
            f32x4 a = acc[ai][bj][m][0] * rs, b = acc[ai][bj][m][1] * rs;
#pragma unroll
            for (int q = 0; q < 4; ++q) { a[q] = sigmoidf_(a[q]); b[q] = sigmoidf_(b[q]); }
            gs[((ai * 2 + bj) * 4 + m) * 512 + tid] = pack8(a, b);
          }
          FENCE();
        }
    } else {
      const int s = u.kind >> 1;
      bf16_t* MB = (bf16_t*)(ws + WS_G1 + G1_MB);
#pragma unroll
      for (int ai = 0; ai < 2; ++ai) {
        u32x4 g[2][4], mo[2][4];
#pragma unroll
        for (int bj = 0; bj < 2; ++bj)
#pragma unroll
          for (int m = 0; m < 4; ++m) {
            if (u.pm < 256) g[bj][m] = gs[((ai * 2 + bj) * 4 + m) * 512 + tid];
            else g[bj][m] = *(const GAS u32x4*)((const bf16_t*)(ws + WS_GMS) + (size_t)((u.pm - 256) * 256 + 128 * ai + 64 * wr + 16 * m + fr) * 3072 + s * 1024 + u.pn * 256 + 128 * bj + 32 * wc + 8 * fq);
            if (s > 0) mo[bj][m] = ms[((ai * 2 + bj) * 4 + m) * 512 + tid]; }
#pragma unroll
        for (int m = 0; m < 4; ++m) {
          const int row = u.pm * 256 + 128 * ai + 64 * wr + 16 * m + fr;
#pragma unroll
          for (int bj = 0; bj < 2; ++bj) {
            const int idx = (ai * 2 + bj) * 4 + m;
            const u32x4 gg = g[bj][m];
            f32x4 a = acc[ai][bj][m][0], b = acc[ai][bj][m][1];
            a[0] *= bflo(gg.x); a[1] *= bfhi(gg.x); a[2] *= bflo(gg.y); a[3] *= bfhi(gg.y);
            b[0] *= bflo(gg.z); b[1] *= bfhi(gg.z); b[2] *= bflo(gg.w); b[3] *= bfhi(gg.w);
            if (s > 0) { const u32x4 mm = mo[bj][m];
              a[0] += bflo(mm.x); a[1] += bfhi(mm.x); a[2] += bflo(mm.y); a[3] += bfhi(mm.y);
              b[0] += bflo(mm.z); b[1] += bfhi(mm.z); b[2] += bflo(mm.w); b[3] += bfhi(mm.w); }
            if (s < 2) ms[idx * 512 + tid] = pack8(a, b);
            else *(GAS u32x4*)(MB + (size_t)row * 1024 + u.pn * 256 + 128 * bj + 32 * wc + 8 * fq) = pack8(a, b);
          }
        }
        FENCE();
      }
    }
  }
};

struct EpiProj {
  const Params* P;
  DI void operator()(Acc& acc, const Unit& u, int wr, int wc, int fr, int fq) const {
    unsigned char* ws = P->ws; OPAQUE(ws);
    bf16_t* PROJ = (bf16_t*)(ws + WS_R2);
#pragma unroll
    for (int ai = 0; ai < 2; ++ai)
#pragma unroll
      for (int m = 0; m < 4; ++m) {
        const int row = u.pm * 256 + 128 * ai + 64 * wr + 16 * m + fr;
#pragma unroll
        for (int bj = 0; bj < 2; ++bj) *(GAS u32x4*)(PROJ + (size_t)row * 1024 + u.pn * 256 + 128 * bj + 32 * wc + 8 * fq) = pack8(acc[ai][bj][m][0], acc[ai][bj][m][1]);
      }
  }
};
struct EpiOut {
  const Params* P; long long dp, ds;
  DI void operator()(Acc& acc, const Unit& u, int wr, int wc, int fr, int fq) const {
    unsigned char* ws = P->ws; float* Y = P->out; OPAQUE(ws); OPAQUE(Y);
    bf16_t* X1B = (bf16_t*)(ws + WS_OCAT); float* SSQ1 = (float*)(ws + WS_SSQ1);
    const int cb = u.pn * 256 + 32 * wc + 8 * fq;
    long long dsel = u.pm < 256 ? dp : ds; asm volatile("" : "+s"(dsel));
    const float* Xs = (const float*)((const char*)Y + dsel);
#pragma unroll
    for (int ai = 0; ai < 2; ++ai)
#pragma unroll
      for (int mp = 0; mp < 2; ++mp) {
        f32x4 xin[2][2][2];
#pragma unroll
        for (int mm = 0; mm < 2; ++mm)
#pragma unroll
          for (int bj = 0; bj < 2; ++bj) {
            const float* xr = Xs + (size_t)(u.pm * 256 + 128 * ai + 64 * wr + 16 * (2 * mp + mm) + fr) * 1024 + cb + 128 * bj;
            xin[mm][bj][0] = *(const GAS f32x4*)(xr); xin[mm][bj][1] = *(const GAS f32x4*)(xr + 4);
          }
#pragma unroll
        for (int mm = 0; mm < 2; ++mm) {
          const int m = 2 * mp + mm;
          const int row = u.pm * 256 + 128 * ai + 64 * wr + 16 * m + fr;
          float s = 0.f;
#pragma unroll
          for (int bj = 0; bj < 2; ++bj) {
            const int c0 = cb + 128 * bj;
            const f32x4 a = xin[mm][bj][0] + acc[ai][bj][m][0], b = xin[mm][bj][1] + acc[ai][bj][m][1];
            s += ss4(a) + ss4(b);
            *(GAS f32x4*)(Y + (size_t)row * 1024 + c0) = a; *(GAS f32x4*)(Y + (size_t)row * 1024 + c0 + 4) = b;
            *(GAS u32x4*)(X1B + (size_t)row * 1024 + c0) = pack8(a, b);
          }
          s = red_fq(s);
          if (fq == 0) *(GAS float*)(SSQ1 + (size_t)row * 16 + u.pn * 4 + wc) = s;
        }
        FENCE();
      }
  }
};
struct EpiPle {
  const Params* P; int write_next_;
  DI void operator()(Acc& acc, const Unit& u, int wr, int wc, int fr, int fq) const {
    if (write_next_) body<true>(acc, u, wr, wc, fr, fq); else body<false>(acc, u, wr, wc, fr, fq);
  }
  template <bool write_next>
  DI void body(Acc& acc, const Unit& u, int wr, int wc, int fr, int fq) const {
    unsigned char* ws = P->ws; float* Y = P->out; OPAQUE(ws); OPAQUE(Y);
    const float* SSQ1 = (const float*)(ws + WS_SSQ1); const bf16_t* PROJ = (const bf16_t*)(ws + WS_R2);
    bf16_t* XB = (bf16_t*)(ws + WS_XB); float* SSQX = (float*)(ws + WS_SSQX);
    float rs8[8];
    rstd8(SSQ1, u.pm * 256 + 64 * wr + fr, fq, 1.0f / 1024.0f, rs8);
    const int cb = u.pn * 256 + 32 * wc + 8 * fq;
#pragma unroll
    for (int ai = 0; ai < 2; ++ai)
#pragma unroll
      for (int mp = 0; mp < 2; ++mp) {
        f32x4 xin[2][2][2]; u32x4 pj[2][2];
#pragma unroll
        for (int mm = 0; mm < 2; ++mm)
#pragma unroll
          for (int bj = 0; bj < 2; ++bj) {
            const size_t off = (size_t)(u.pm * 256 + 128 * ai + 64 * wr + 16 * (2 * mp + mm) + fr) * 1024 + cb + 128 * bj;
            xin[mm][bj][0] = *(const GAS f32x4*)(Y + off); xin[mm][bj][1] = *(const GAS f32x4*)(Y + off + 4); pj[mm][bj] = *(const GAS u32x4*)(PROJ + off);
          }
#pragma unroll
        for (int mm = 0; mm < 2; ++mm) {
          const int m = 2 * mp + mm;
          const int row = u.pm * 256 + 128 * ai + 64 * wr + 16 * m + fr;
          const float rs = rs8[ai * 4 + m];
          float s = 0.f;
#pragma unroll
          for (int bj = 0; bj < 2; ++bj) {
            const int c0 = cb + 128 * bj;
            const u32x4 pq = pj[mm][bj];
            f32x4 a = acc[ai][bj][m][0] * rs, b = acc[ai][bj][m][1] * rs;
            const f32x4 xa = xin[mm][bj][0], xb = xin[mm][bj][1];
            a[0] = xa[0] + sigmoidf_(a[0]) * bflo(pq.x); a[1] = xa[1] + sigmoidf_(a[1]) * bfhi(pq.x); a[2] = xa[2] + sigmoidf_(a[2]) * bflo(pq.y); a[3] = xa[3] + sigmoidf_(a[3]) * bfhi(pq.y);
            b[0] = xb[0] + sigmoidf_(b[0]) * bflo(pq.z); b[1] = xb[1] + sigmoidf_(b[1]) * bfhi(pq.z); b[2] = xb[2] + sigmoidf_(b[2]) * bflo(pq.w); b[3] = xb[3] + sigmoidf_(b[3]) * bfhi(pq.w);
            *(GAS f32x4*)(Y + (size_t)row * 1024 + c0) = a; *(GAS f32x4*)(Y + (size_t)row * 1024 + c0 + 4) = b;
            if (write_next) { s += ss4(a) + ss4(b); *(GAS u32x4*)(XB + (size_t)row * 1024 + c0) = pack8(a, b); }
          }
          if (write_next) { s = red_fq(s); if (fq == 0) *(GAS float*)(SSQX + (size_t)row * 16 + u.pn * 4 + wc) = s; }
        }
        FENCE();
      }
  }
};

#define XB_TMO      128
#define XB_XCNT(j)  (256  + 64 * (j))
#define XB_XSUB(j)  (1280 + 64 * (j))
#define XB_XGEN(j)  (2304 + 64 * (j))
#define XB_TOP      3328
#define XB_TOPGEN   3392
#define XCD_BAR_WORDS 3456
#define XB_SPIN_CAP (1u << 18)
DI unsigned xb_ld(unsigned* p)              { return __hip_atomic_load(p, __ATOMIC_RELAXED, __HIP_MEMORY_SCOPE_AGENT); }
DI unsigned xb_add(unsigned* p, unsigned v) { return __hip_atomic_fetch_add(p, v, __ATOMIC_RELAXED, __HIP_MEMORY_SCOPE_AGENT); }
DI unsigned xb_xcc_id() { return (unsigned)__builtin_amdgcn_s_getreg((3 << 11) | 20) & 0xFu; }
#define XB_SPIN(cond, bar) do { unsigned _sp = 0; while (cond) { __builtin_amdgcn_s_sleep(1); \
    if ((++_sp & 255u) == 0u) { if (xb_ld(&(bar)[XB_TMO])) break; if (_sp > XB_SPIN_CAP) { atomicAdd(&(bar)[XB_TMO], 1u); break; } } } } while (0)
struct XcdBarrier { unsigned* bar; unsigned x; volatile LAS unsigned* st; };
DI XcdBarrier xcd_barrier_post(unsigned* bar, volatile LAS unsigned* st) {
  XcdBarrier b; b.bar = bar; b.x = xb_xcc_id(); b.st = st;
  if (threadIdx.x == 0) (void)xb_add(&bar[XB_XCNT(b.x)], 1u);
  return b;
}
DI void xcd_barrier_complete(unsigned* bar, unsigned x, unsigned& nloc, unsigned& nx) {
  const unsigned G = gridDim.x * gridDim.y * gridDim.z;
  unsigned sum, cnt, mine, sp = 0u;
  for (;;) {
    sum = 0u; cnt = 0u; mine = 0u;
#pragma unroll
    for (unsigned j = 0; j < 16; ++j) { const unsigned c = xb_ld(&bar[XB_XCNT(j)]); sum += c; cnt += (c > 0u) ? 1u : 0u; mine = (j == x) ? c : mine; }
    if (sum == G) break;
    __builtin_amdgcn_s_sleep(1);
    if ((++sp & 255u) == 0u) { if (xb_ld(&bar[XB_TMO])) break; if (sp > XB_SPIN_CAP) { atomicAdd(&bar[XB_TMO], 1u); break; } }
  }
  nloc = mine > 0u ? mine : 1u; nx = cnt > 0u ? cnt : 1u;
}
DI void xcd_barrier(const XcdBarrier& b) {
  asm volatile("s_waitcnt vmcnt(0)" ::: "memory");
  __syncthreads();
  if (threadIdx.x == 0) {
    unsigned* bar = b.bar;
    __builtin_amdgcn_s_waitcnt(0);
    unsigned nloc = b.st[0], nx = b.st[1];
    if (nloc == 0u) { xcd_barrier_complete(bar, b.x, nloc, nx); b.st[0] = nloc; b.st[1] = nx; }
    const unsigned old = xb_add(&bar[XB_XSUB(b.x)], 1u);
    const unsigned gen = old / nloc;
    if (old + 1u == (gen + 1u) * nloc) {
      __builtin_amdgcn_fence(__ATOMIC_RELEASE, "agent");
      asm volatile("s_waitcnt vmcnt(0)" ::: "memory");
      const unsigned og = xb_add(&bar[XB_TOP], 1u);
      const unsigned tg = og / nx;
      if (og + 1u == (tg + 1u) * nx) xb_add(&bar[XB_TOPGEN], 1u);
      else XB_SPIN(xb_ld(&bar[XB_TOPGEN]) == tg, bar);
      __builtin_amdgcn_fence(__ATOMIC_ACQUIRE, "agent");
      xb_add(&bar[XB_XGEN(b.x)], 1u);
      asm volatile("s_waitcnt vmcnt(0)" ::: "memory");
    } else {
      XB_SPIN(xb_ld(&bar[XB_XGEN(b.x)]) == gen, bar);
      __builtin_amdgcn_fence(__ATOMIC_ACQUIRE, "agent");
      asm volatile("s_waitcnt vmcnt(0)" ::: "memory");
    }
  }
  __syncthreads();
}

__global__ void __launch_bounds__(512) fwd_megakernel(Params p) {
  extern __shared__ __attribute__((aligned(16))) unsigned char lds_raw[];
  LAS unsigned char* lds = (LAS unsigned char*)lds_raw;
  cg::grid_group grid = cg::this_grid();
  Frame F;
  F.P = &p;
  F.out = p.out; F.ws = p.ws; F.G = gridDim.x; F.layer = 0;
  { const int bx = blockIdx.x; F.vcu = (F.G % 8 == 0) ? (bx % 8) * (F.G / 8) + bx / 8 : bx; }

  volatile LAS unsigned* xst = (volatile LAS unsigned*)(lds + LDS_BYTES - 16);
  if (threadIdx.x == 0) { xst[0] = 0u; xst[1] = 0u; }
  __syncthreads();
  (void)xcd_barrier_post((unsigned*)(p.ws + WS_BAR), xst);
#define XBAR() do { XcdBarrier b_; b_.bar = (unsigned*)(F.W() + WS_BAR); b_.x = xb_xcc_id(); b_.st = (volatile LAS unsigned*)(lds + LDS_BYTES - 16); xcd_barrier(b_); } while (0)
  REPLOOP(REP_P0) { prep_weights(F, lds); prep_misc(F); }
  grid.sync();

#pragma unroll 1
  for (int layer = 0; layer < 2; ++layer) {
    F.layer = layer;
#define REFRESH() asm volatile("" : "+s"(F.vcu), "+s"(F.G), "+s"(F.ws), "+s"(F.out))
    REFRESH();
    if (STAGE_LIMIT >= 2) REPLOOP(REP_P2) {
      SchedZ S{F.W(), layer, F.G, F.vcu};
      EpiZ E{&p, layer};
      pg8::gemm_phase(lds, 2048, 2048, S, E);
    }
    XBAR();
    REFRESH();
    if (STAGE_LIMIT >= 3) REPLOOP(REP_P3) {
      SchedQ S{F.W(), layer, F.G, F.vcu};
      EpiQ E{&p, layer};
      pg8::gemm_phase(lds, 512, 512, S, E);
      post_kv(F);
      pooled_rows(F);
      conv_layer(F);
      __syncthreads();
      if (STAGE_LIMIT >= 4) ca_phase(F, lds);
    }
    XBAR();
    REFRESH();
    if (STAGE_LIMIT >= 5) REPLOOP(REP_P4) {
      SchedKV S{F.W(), layer, F.G, F.vcu};
      EpiKV E{&p, layer};
      pg8::gemm_phase(lds, 256, 256, S, E);
      SchedRows<WS_POOLED, WL_WPOOL, 512, 512, 4, 1> S2{F.W(), layer, F.G, F.vcu};
      EpiPool E2{&p};
      pg8::gemm_phase(lds, 512, 512, S2, E2);
    }
    XBAR();
    REFRESH();
    if (STAGE_LIMIT >= 6) REPLOOP(REP_P5) mla_phase(F, lds);
    XBAR();
    REFRESH();
    if (STAGE_LIMIT >= 6) mla_combine(F);
    XBAR();
    REFRESH();
    if (STAGE_LIMIT >= 7) REPLOOP(REP_P6) {
      SchedMerge S{F.W(), layer, F.G, F.vcu};
      EpiMerge E{&p};
      pg8::gemm_phase(lds, 2048, 2048, S, E);
    }
    XBAR();
    REFRESH();
    if (STAGE_LIMIT >= 8) {
      SchedRows<WS_PB, WL_WPROJ, 512, 512, 4, 4> S1{F.W(), layer, F.G, F.vcu};
      EpiProj E1{&p};
      pg8::gemm_phase(lds, 512, 512, S1, E1);
      SchedRows<WS_G1 + G1_MB, WL_WOUT, 2048, 2048, 16, 4> S2{F.W(), layer, F.G, F.vcu};
      EpiOut E2{&p, layer == 0 ? (long long)((const char*)p.in[0] - (const char*)p.out) : 0ll, layer == 0 ? (long long)((const char*)p.in[1] - (const char*)p.out) - (long long)MP * 4096 : 0ll};
      stagger_odd(F.vcu, 4);
      pg8::gemm_phase(lds, 2048, 2048, S2, E2);
    }
    XBAR();
    REFRESH();
    if (STAGE_LIMIT >= 9) {
      SchedRows<WS_OCAT, WL_WPG, 2048, 2048, 16, 4> S{F.W(), layer, F.G, F.vcu};
      EpiPle E{&p, layer == 0 ? 1 : 0};
      stagger_odd(F.vcu, 4);
      pg8::gemm_phase(lds, 2048, 2048, S, E);
    }
    if (layer == 0) XBAR();
  }
}

extern "C" void kernel_launch(void* const* d_in, const int* in_sizes, int n_in, void* d_out, int out_size, void* d_ws, size_t ws_size, hipStream_t stream) {
  static int grid_blocks = 0;
  if (grid_blocks == 0) {
    if (n_in != 31 || (size_t)out_size != O_END || ws_size < WS_END) {
      fprintf(stderr, "kernel_launch: unexpected shapes n_in=%d out=%d (want %zu) ws=%zu (need %zu)\n", n_in, out_size, (size_t)O_END, ws_size, (size_t)WS_END);
      grid_blocks = -1; return;
    }
    int dev = 0, cus = 0, per_cu = 0;
    hipGetDevice(&dev);
    hipDeviceGetAttribute(&cus, hipDeviceAttributeMultiprocessorCount, dev);
    hipFuncSetAttribute((const void*)fwd_megakernel, hipFuncAttributeMaxDynamicSharedMemorySize, LDS_BYTES);
    hipOccupancyMaxActiveBlocksPerMultiprocessor(&per_cu, (const void*)fwd_megakernel, 512, LDS_BYTES);
    if (per_cu < 1) { fprintf(stderr, "kernel_launch: occupancy query says %d blocks/CU\n", per_cu); per_cu = 1; }
    grid_blocks = cus;
    if (grid_blocks > 256) grid_blocks = 256;
  }
  if (grid_blocks < 0) return;
  (void)hipMemsetAsync((unsigned char*)d_ws + WS_BAR, 0, XCD_BAR_WORDS * 4, stream);
  Params p{};
  for (int i = 0; i < 31; ++i) p.in[i] = (const float*)d_in[i];
  p.out = (float*)d_out; p.ws = (unsigned char*)d_ws; p.G = grid_blocks; p.pad = 0;
  void* args[] = {&p};
  hipError_t e = hipLaunchCooperativeKernel((const void*)fwd_megakernel, dim3(grid_blocks), dim3(512), args, LDS_BYTES, stream);
  if (e != hipSuccess) fprintf(stderr, "cooperative launch failed: %s (grid %d)\n", hipGetErrorString(e), grid_blocks);
}
```

```cpp
#include <hip/hip_runtime.h>
#include <hip/hip_cooperative_groups.h>
#include <cstdio>
#include <cstdint>
namespace cg = cooperative_groups;

#define LAS __attribute__((address_space(3)))
#define DI __device__ __forceinline__
typedef unsigned short bf16_t;
typedef short bf16x8 __attribute__((ext_vector_type(8)));
typedef float f32x2 __attribute__((ext_vector_type(2)));
typedef float f32x4 __attribute__((ext_vector_type(4)));
typedef float f32x16 __attribute__((ext_vector_type(16)));
typedef unsigned u32x2 __attribute__((ext_vector_type(2)));
typedef unsigned u32x4 __attribute__((ext_vector_type(4)));
typedef __bf16 bf16x2_t __attribute__((ext_vector_type(2)));

#ifndef STAGE_LIMIT
#define STAGE_LIMIT 99
#endif
#define REP_P0 1
#define REP_P2 1
#define REP_P3 1
#define REP_P4 1
#define REP_P5 1
#define REP_P6 1
#define DUP_KV 1
#define DUP_Q 1
#define DUP_CA 1
#define DUP_PROJ 1
#define REPLOOP(n) for (int rep_ = 0, reps_ = ((n) == 1 ? 1 : orep(n)); rep_ < reps_; ++rep_)

constexpr int MP = 65536, MS = 512, MROWS = MP + MS, MT = MROWS / 256;
constexpr int TP = 8192, TS = 64, PAST = 4096, TKS = PAST + TS;
constexpr int KVROWS = MP + 8 * TKS, KVT = KVROWS / 256;
constexpr int CAKS = 512 + TS;
constexpr float EPSF = 1e-6f;
constexpr float LOG2E = 1.4426950408889634f;
constexpr float QSCALE_MLA = 0.10206207261596577f * LOG2E;
constexpr float QSCALE_CA = 0.125f * LOG2E;

constexpr size_t O_Y = 0;
constexpr size_t O_CKVP = (size_t)MROWS * 1024;
constexpr size_t O_KRP = O_CKVP + (size_t)2 * 8 * 8192 * 128;
constexpr size_t O_CKP = O_KRP + (size_t)2 * 8 * 8192 * 32;
constexpr size_t O_CVP = O_CKP + (size_t)2 * 8 * 512 * 256;
constexpr size_t O_PLP = O_CVP + (size_t)2 * 8 * 512 * 256;
constexpr size_t O_CKVS = O_PLP + (size_t)2 * 8 * 15 * 256;
constexpr size_t O_KRS = O_CKVS + (size_t)2 * 8 * 64 * 128;
constexpr size_t O_CKS = O_KRS + (size_t)2 * 8 * 64 * 32;
constexpr size_t O_CVS = O_CKS + (size_t)2 * 8 * 64 * 256;
constexpr size_t O_PLS = O_CVS + (size_t)2 * 8 * 64 * 256;
constexpr size_t O_END = O_PLS + (size_t)2 * 8 * 15 * 256;

constexpr size_t AL(size_t x) { return (x + 255) & ~(size_t)255; }
constexpr size_t WL_WIN = 0;
constexpr size_t WL_WUQ = WL_WIN + (size_t)5632 * 1024 * 2;
constexpr size_t WL_WUK = WL_WUQ + (size_t)768 * 256 * 2;
constexpr size_t WL_WUV = WL_WUK + (size_t)512 * 128 * 2;
constexpr size_t WL_WPOOL = WL_WUV + (size_t)512 * 128 * 2;
constexpr size_t WL_WCAT = WL_WPOOL + (size_t)256 * 256 * 2;
constexpr size_t WL_WOUT = WL_WCAT + (size_t)1024 * 1024 * 2;
constexpr size_t WL_WPG = WL_WOUT + (size_t)1024 * 1024 * 2;
constexpr size_t WL_WPROJ = WL_WPG + (size_t)1024 * 1024 * 2;
constexpr size_t WL_SIZE = WL_WPROJ + (size_t)1024 * 256 * 2;
constexpr size_t WS_W = 0;
constexpr size_t WS_CS = AL(WS_W + 2 * WL_SIZE);
constexpr size_t WS_XB = AL(WS_CS + (size_t)8192 * 32 * 4);
constexpr size_t WS_SSQX = AL(WS_XB + (size_t)MROWS * 1024 * 2);
constexpr size_t WS_SSQ1 = AL(WS_SSQX + (size_t)MROWS * 16 * 4);
constexpr size_t WS_SSQQ = AL(WS_SSQ1 + (size_t)MROWS * 16 * 4);
constexpr size_t WS_G1 = AL(WS_SSQQ + (size_t)MROWS * 4 * 4);
constexpr size_t G1_HQ = 0;
constexpr size_t G1_HKV = AL(G1_HQ + (size_t)MROWS * 256 * 2);
constexpr size_t G1_QC = AL(G1_HKV + (size_t)MROWS * 160 * 4);
constexpr size_t G1_KC = AL(G1_QC + (size_t)MROWS * 256 * 2);
constexpr size_t G1_VCT = AL(G1_KC + (size_t)MROWS * 256 * 2);
constexpr size_t G1_UB = AL(G1_VCT + (size_t)8 * 256 * 8192 * 2);
constexpr size_t G1_GC = AL(G1_UB + (size_t)MROWS * 256 * 2);
constexpr size_t G1_ENDA = AL(G1_GC + (size_t)MROWS * 256 * 2);
constexpr size_t G1_KP = 0;
constexpr size_t G1_KPS = AL(G1_KP + (size_t)8 * 8 * 8192 * 96 * 2);
constexpr size_t G1_VT = AL(G1_KPS + (size_t)8 * 8 * TKS * 96 * 2);
constexpr size_t G1_VTS = AL(G1_VT + (size_t)8 * 512 * 8192 * 2);
constexpr size_t G1_ENDB = AL(G1_VTS + (size_t)8 * 512 * TKS * 2);
constexpr size_t G1_MB = 0;
constexpr size_t G1_SIZE = G1_ENDA > G1_ENDB ? G1_ENDA : G1_ENDB;
constexpr size_t WS_R2 = AL(WS_G1 + G1_SIZE);
constexpr size_t R2_QP = 0;
constexpr size_t R2_GA = AL(R2_QP + (size_t)MROWS * 768 * 2);
constexpr size_t R2_SIZE = AL(R2_GA + (size_t)MROWS * 512 * 2);
constexpr size_t WS_GB = AL(WS_R2 + R2_SIZE);
constexpr size_t WS_POOLED = AL(WS_GB + (size_t)MROWS * 256 * 2);
constexpr size_t WS_OCAT = AL(WS_POOLED + (size_t)MROWS * 256 * 2);
constexpr size_t WS_CKVB = AL(WS_OCAT + (size_t)MROWS * 1024 * 2);
constexpr size_t WS_KRB = AL(WS_CKVB + (size_t)KVROWS * 128 * 2);
constexpr size_t WS_KCS = AL(WS_KRB + (size_t)KVROWS * 32 * 2);
constexpr size_t WS_VCTS = AL(WS_KCS + (size_t)2 * 8 * CAKS * 256 * 2);
constexpr size_t WS_PB = AL(WS_VCTS + (size_t)2 * 8 * 256 * CAKS * 2);
constexpr size_t WS_BAR = AL(WS_PB + (size_t)MROWS * 256 * 2);
constexpr size_t WS_PART = AL(WS_BAR + 3456 * 4);
constexpr size_t WS_GMS = AL(WS_PART + (size_t)256 * 64 * 66 * 4);
constexpr size_t WS_END = AL(WS_GMS + (size_t)MS * 3072 * 2);
constexpr size_t P6_SCR_PER_WG = 2 * 128 * 1024;
static_assert(256 * P6_SCR_PER_WG <= R2_SIZE, "P6 scratch must fit region 2");
static_assert((size_t)MROWS * 1024 * 2 <= R2_SIZE, "PROJ must fit region 2");
static_assert((size_t)MROWS * 1024 * 2 <= G1_SIZE, "MB must fit region 1");

constexpr int LDS_BYTES = 144 * 1024;

struct Params {
  const float* in[31];
  float* out;
  unsigned char* ws;
  int G, pad;
};

#define GAS __attribute__((address_space(1)))
template <class T> DI T* GP(T* p) { return p; }
DI int orep2(int n) { asm volatile("" : "+s"(n)); return n; }
DI void stagger_odd(int vcu, int n) { if (vcu & 1) { for (int i = 0, m = orep2(n); i < m; ++i) __builtin_amdgcn_s_sleep(127); } }
DI int orep(int n) { asm volatile("" : "+s"(n)); return n; }
DI int otid() { int t = threadIdx.x; asm volatile("" : "+v"(t)); return t; }
DI int obid() { int t = blockIdx.x; asm volatile("" : "+s"(t)); return t; }
DI int ogdim() { int t = gridDim.x; asm volatile("" : "+s"(t)); return t; }
DI unsigned pk2(float lo, float hi) { f32x2 v = {lo, hi}; bf16x2_t b = __builtin_convertvector(v, bf16x2_t); return __builtin_bit_cast(unsigned, b); }
DI float bflo(unsigned u) { return __uint_as_float(u << 16); }
DI float bfhi(unsigned u) { return __uint_as_float(u & 0xffff0000u); }
DI float sigmoidf_(float x) { return __builtin_amdgcn_rcpf(1.0f + __builtin_amdgcn_exp2f(-x * LOG2E)); }
DI float siluf_(float x) { return x * sigmoidf_(x); }
typedef _Float16 h2_t __attribute__((ext_vector_type(2)));
DI unsigned pkh(float a, float b) { return __builtin_bit_cast(unsigned, __builtin_amdgcn_cvt_pkrtz(a, b)); }
DI float hlo(unsigned u) { const h2_t h = __builtin_bit_cast(h2_t, u); return (float)h[0]; }
DI float hhi(unsigned u) { const h2_t h = __builtin_bit_cast(h2_t, u); return (float)h[1]; }
DI u32x4 pack8h(const f32x4 a, const f32x4 b) { u32x4 w; w.x = pkh(a[0], a[1]); w.y = pkh(a[2], a[3]); w.z = pkh(b[0], b[1]); w.w = pkh(b[2], b[3]); return w; }
DI void unpack8h(const u32x4 w, f32x4& a, f32x4& b) { a[0] = hlo(w.x); a[1] = hhi(w.x); a[2] = hlo(w.y); a[3] = hhi(w.y); b[0] = hlo(w.z); b[1] = hhi(w.z); b[2] = hlo(w.w); b[3] = hhi(w.w); }
DI u32x4 pack8(const f32x4 a, const f32x4 b) { u32x4 w; w.x = pk2(a[0], a[1]); w.y = pk2(a[2], a[3]); w.z = pk2(b[0], b[1]); w.w = pk2(b[2], b[3]); return w; }
DI float rstd16(const float* p, float invn) {
  const f32x4 a = *(const GAS f32x4*)p, b = *(const GAS f32x4*)(p + 4), c = *(const GAS f32x4*)(p + 8), d = *(const GAS f32x4*)(p + 12);
  const float s = ((a[0] + a[1]) + (a[2] + a[3])) + ((b[0] + b[1]) + (b[2] + b[3])) + ((c[0] + c[1]) + (c[2] + c[3])) + ((d[0] + d[1]) + (d[2] + d[3]));
  return __builtin_amdgcn_rsqf(s * invn + EPSF);
}
template <int K> DI float swz_xor(float v) { return __builtin_bit_cast(float, __builtin_amdgcn_ds_swizzle(__builtin_bit_cast(int, v), 0x1F | (K << 10))); }
DI float sum_xor32(float v) { auto r = __builtin_amdgcn_permlane32_swap(__float_as_uint(v), __float_as_uint(v), false, false); return __uint_as_float(r[0]) + __uint_as_float(r[1]); }
DI float max_xor32(float v) { auto r = __builtin_amdgcn_permlane32_swap(__float_as_uint(v), __float_as_uint(v), false, false); return fmaxf(__uint_as_float(r[0]), __uint_as_float(r[1])); }
DI float get_xor32(float v, bool upper) { auto r = __builtin_amdgcn_permlane32_swap(__float_as_uint(v), __float_as_uint(v), false, false); return __uint_as_float(upper ? r[0] : r[1]); }
DI float red_fq(float s) { s += swz_xor<16>(s); return sum_xor32(s); }
DI float wave_sum(float s) { s += swz_xor<1>(s); s += swz_xor<2>(s); s += swz_xor<4>(s); s += swz_xor<8>(s); s += swz_xor<16>(s); return sum_xor32(s); }
DI void rstd8(const float* SSQ, int rowbase, int fq, float invn, float (&rs)[8]) {
  f32x4 q[8];
#pragma unroll
  for (int k = 0; k < 8; ++k) q[k] = *(const GAS f32x4*)(SSQ + (size_t)(rowbase + 128 * (k >> 2) + 16 * (k & 3)) * 16 + 4 * fq);
#pragma unroll
  for (int k = 0; k < 8; ++k) rs[k] = __builtin_amdgcn_rsqf(red_fq((q[k][0] + q[k][1]) + (q[k][2] + q[k][3])) * invn + EPSF);
}
DI float ss4(const f32x4 v) { return (v[0] * v[0] + v[1] * v[1]) + (v[2] * v[2] + v[3] * v[3]); }

namespace pg8 {
constexpr int BM = 256, BK = 64, HALF = 128, HTB = HALF * BK * 2, STAGE_BYTES = 8 * HTB;
DI int lds_byte(int r, int c) { const int st = (r >> 4) * 2 + (c >> 5), rr = r & 15, cc = c & 31, ob = rr * 64 + cc * 2; return st * 1024 + (ob ^ (((ob >> 9) & 1) << 5)); }
DI void stage_rc(int b, int& R, int& C) { const int st = b / 1024, sb = b % 1024, swz = sb ^ (((sb >> 9) & 1) << 5); R = (st >> 1) * 16 + swz / 64; C = (st & 1) * 32 + (swz % 64) / 2; }
DI int perm32(int rho) { const int n = rho >> 4, i = rho & 15; return 8 * (i >> 2) + 4 * n + (i & 3); }
struct Unit { const char* A; const char* B; int nt, pm, pn, kind; };
template <class Epi, class Sched>
DI void gemm_phase(LAS unsigned char* lds, const int lda, const int ldb, const Sched& S, const Epi& E) {
  const int tid = otid(), wid = __builtin_amdgcn_readfirstlane(tid >> 6), lane = tid & 63, wr = wid >> 2, wc = wid & 3, fr = lane & 15, fq = lane >> 4;
  unsigned voffA[2], voffB[2];
#pragma unroll
  for (int i = 0; i < 2; ++i) { int R, C; stage_rc(tid * 16 + i * 8192, R, C); const int Rb = (R & ~31) + perm32(R & 31);
    voffA[i] = (unsigned)(R * lda + C * 2); voffB[i] = (unsigned)(Rb * ldb + C * 2); }
  const size_t kstep = (size_t)(BK * 2);
  const size_t hsA = (size_t)HALF * lda, hsB = (size_t)HALF * ldb;
  const unsigned ldsw = (unsigned)wid * 1024u;
  const int aoff = lds_byte(wr * 64 + fr, fq * 8), boff = lds_byte(wc * 32 + fr, fq * 8);
#define PG8_SA(b, h) (((b) * 2 + (h)) * HTB)
#define PG8_SB(b, h) ((4 + (b) * 2 + (h)) * HTB)
#define PG8_STAGE(bufoff, gbase, voff) do { _Pragma("unroll") for (int _i = 0; _i < 2; ++_i) \
    __builtin_amdgcn_global_load_lds((const unsigned*)((const char*)(gbase) + (voff)[_i]), (LAS unsigned*)(lds + (bufoff) + ldsw + _i * 8192), 16, 0, 0); } while (0)
#define PG8_LDA(dst, b, h) do { _Pragma("unroll") for (int m = 0; m < 4; ++m) _Pragma("unroll") for (int k = 0; k < 2; ++k) dst[m][k] = *(const LAS bf16x8*)(lds + PG8_SA(b, h) + aoff + m * 2048 + k * 1024); } while (0)
#define PG8_LDB(dst, b, h) do { _Pragma("unroll") for (int n = 0; n < 2; ++n) _Pragma("unroll") for (int k = 0; k < 2; ++k) dst[n][k] = *(const LAS bf16x8*)(lds + PG8_SB(b, h) + boff + n * 2048 + k * 1024); } while (0)
#define PG8_MMA(ai, bj, At, Bt) do { __builtin_amdgcn_s_setprio(1); _Pragma("unroll") for (int m = 0; m < 4; ++m) _Pragma("unroll") for (int n = 0; n < 2; ++n) _Pragma("unroll") for (int k = 0; k < 2; ++k) \
    acc[ai][bj][m][n] = __builtin_amdgcn_mfma_f32_16x16x32_bf16(Bt[n][k], At[m][k], acc[ai][bj][m][n], 0, 0, 0); __builtin_amdgcn_s_setprio(0); } while (0)
#define PG8_WAIT_V(n) asm volatile("s_waitcnt vmcnt(" #n ")" ::: "memory")
#define PG8_WAIT_L(n) asm volatile("s_waitcnt lgkmcnt(" #n ")" ::: "memory")
#define PG8_BAR __builtin_amdgcn_s_barrier()
#define PG8_SCHED __builtin_amdgcn_sched_barrier(0)
  Unit cur, nxt; int ui = 0;
  if (!S.next(0, cur)) return;
  f32x4 acc[2][2][4][2];
#pragma unroll
  for (int a = 0; a < 2; ++a)
#pragma unroll
    for (int b = 0; b < 2; ++b)
#pragma unroll
      for (int m = 0; m < 4; ++m)
#pragma unroll
        for (int n = 0; n < 2; ++n) acc[a][b][m][n] = (f32x4){0.f, 0.f, 0.f, 0.f};
  bf16x8 At[4][2], B0[2][2], B1[2][2];
  const char* cA = cur.A; const char* cB = cur.B;
  PG8_STAGE(PG8_SB(0, 0), cB, voffB); PG8_STAGE(PG8_SB(0, 1), cB + hsB, voffB); PG8_STAGE(PG8_SA(0, 0), cA, voffA); PG8_STAGE(PG8_SA(0, 1), cA + hsA, voffA);
  if (wr == 1) PG8_BAR;
  PG8_WAIT_V(2); PG8_BAR;
  PG8_STAGE(PG8_SB(1, 0), cB + kstep, voffB); PG8_STAGE(PG8_SA(1, 0), cA + kstep, voffA); PG8_STAGE(PG8_SB(1, 1), cB + hsB + kstep, voffB);
  PG8_WAIT_V(6); PG8_BAR;
  for (;;) {
    const bool has_next = S.next(ui + 1, nxt);
    const char* nA = has_next ? nxt.A : cA; const char* nB = has_next ? nxt.B : cB;
    const int nt = cur.nt;
    for (int t = 0; t < nt; t += 2) {
      const bool last = (t == nt - 2);
      asm volatile("" : "+v"(voffA[0]), "+v"(voffA[1]), "+v"(voffB[0]), "+v"(voffB[1]));
      const char* a1 = cA + (size_t)(t + 1) * kstep;
      const char* a2 = last ? nA : cA + (size_t)(t + 2) * kstep; const char* b2 = last ? nB : cB + (size_t)(t + 2) * kstep;
      const char* a3 = a2 + kstep; const char* b3 = b2 + kstep;
      PG8_LDB(B0, 0, 0); PG8_LDB(B1, 0, 1); PG8_SCHED; PG8_LDA(At, 0, 0); PG8_STAGE(PG8_SA(1, 1), a1 + hsA, voffA);
      PG8_WAIT_V(8); PG8_WAIT_L(0); PG8_BAR; PG8_MMA(0, 0, At, B0); PG8_MMA(0, 1, At, B1); PG8_BAR; PG8_SCHED;
      PG8_LDA(At, 0, 1); PG8_STAGE(PG8_SB(0, 0), b2, voffB); PG8_STAGE(PG8_SB(0, 1), b2 + hsB, voffB); PG8_STAGE(PG8_SA(0, 0), a2, voffA);
      PG8_WAIT_V(8); PG8_WAIT_L(0); PG8_BAR; PG8_MMA(1, 0, At, B0); PG8_MMA(1, 1, At, B1); PG8_BAR; PG8_SCHED;
      PG8_LDB(B0, 1, 0); PG8_LDB(B1, 1, 1); PG8_SCHED; PG8_LDA(At, 1, 0); PG8_STAGE(PG8_SA(0, 1), a2 + hsA, voffA);
      PG8_WAIT_V(8); PG8_WAIT_L(0); PG8_BAR; PG8_MMA(0, 0, At, B0); PG8_MMA(0, 1, At, B1); PG8_BAR; PG8_SCHED;
      PG8_LDA(At, 1, 1); PG8_STAGE(PG8_SB(1, 0), b3, voffB); PG8_STAGE(PG8_SB(1, 1), b3 + hsB, voffB); PG8_STAGE(PG8_SA(1, 0), a3, voffA);
      PG8_WAIT_V(8); PG8_WAIT_L(0); PG8_BAR; PG8_MMA(1, 0, At, B0); PG8_MMA(1, 1, At, B1); PG8_BAR; PG8_SCHED;
    }
    if (wr == 0) PG8_BAR;
    { const int t2 = otid(), w2 = __builtin_amdgcn_readfirstlane(t2 >> 6), l2 = t2 & 63; E(acc, cur, w2 >> 2, w2 & 3, l2 & 15, l2 >> 4); }
    if (!has_next) break;
#pragma unroll
    for (int a = 0; a < 2; ++a)
#pragma unroll
      for (int b = 0; b < 2; ++b)
#pragma unroll
        for (int m = 0; m < 4; ++m)
#pragma unroll
          for (int n = 0; n < 2; ++n) acc[a][b][m][n] = (f32x4){0.f, 0.f, 0.f, 0.f};
    cur = nxt; cA = nA; cB = nB; ++ui;
    if (wr == 1) PG8_BAR;
  }
  PG8_WAIT_V(0);
  PG8_BAR;
#undef PG8_SA
#undef PG8_SB
#undef PG8_STAGE
#undef PG8_LDA
#undef PG8_LDB
#undef PG8_MMA
#undef PG8_WAIT_V
#undef PG8_WAIT_L
#undef PG8_BAR
#undef PG8_SCHED
}
}
using pg8::Unit;
typedef f32x4 Acc[2][2][4][2];

struct Frame {
  const Params* P;
  float* out;
  unsigned char* ws;
  int G, vcu, layer;
  DI const float* in(int idx) const { return GP(P->in[idx]); }
  DI const float* lin(int idx, size_t per_layer) const { return GP(P->in[idx]) + (size_t)layer * per_layer; }
  DI unsigned char* W() const { return GP(ws); }
  DI float* O() const { return GP(out); }
  DI unsigned char* wl(size_t off) const { return GP(ws) + WS_W + (size_t)layer * WL_SIZE + off; }
  DI unsigned char* g1(size_t off) const { return GP(ws) + WS_G1 + off; }
  DI unsigned char* r2(size_t off) const { return GP(ws) + WS_R2 + off; }
};

DI int map_col(int kind, int base, int r) {
  switch (kind) {
    case 0: return base + r;
    case 1: {
      if (r < 256) return r;
      if (r < 512) { const int c = r - 256; return c < 160 ? 256 + c : -1; }
      if (r < 1024) return 416 + (r - 512);
      if (r < 1280) return 928 + (r - 1024);
      if (r < 1536) return 1184 + (r - 1280);
      if (r < 2048) { const int c = (r - 1536) & 255, bj = c >> 7, wc = (c >> 5) & 3, j = c & 31; return (r < 1792 ? 1440 : 1696) + wc * 64 + 32 * bj + j; }
      if (r < 2304) return 2208 + (r - 2048);
      if (r < 2560) return 1952 + (r - 2304);
      return 2464 + (r - 2560);
    }
    case 2: {
      const int pn = r >> 8, c = r & 255, bj = c >> 7, wc = (c >> 5) & 3, j = c & 31;
      if (pn < 2) return (4 * pn + wc) * 96 + 32 * bj + j;
      return (2 * wc + bj) * 96 + 64 + j;
    }
    case 3: {
      const int pn = r >> 8, c = r & 255, bj = c >> 7, wc = (c >> 5) & 3, j = c & 31;
      return (4 * pn + wc) * 128 + 32 * bj + j;
    }
    default: return (r >> 6) * 128 + 64 + (r & 63);
  }
}
struct PrepJob { int dst_off_lo, dst_off_hi; int ldd, koff, src, nsrc, K, nrows, kind, base, gain; };
__device__ const int PREP_JOBS[9][10] = {
  {(int)WL_WIN, 1024, 0, 10, 5536, 1024, 5632, 1, 0, 9},
  {(int)WL_WUQ, 256, 0, 12, 768, 256, 768, 2, 0, 11},
  {(int)WL_WUK, 128, 0, 14, 1024, 128, 512, 3, 0, -1},
  {(int)WL_WUV, 128, 0, 14, 1024, 128, 512, 4, 0, -1},
  {(int)WL_WCAT, 1024, 0, 19, 1024, 512, 1024, 0, 0, -1},
  {(int)WL_WCAT, 1024, 512, 22, 1024, 256, 1024, 0, 0, -1},
  {(int)WL_WCAT, 1024, 768, 26, 1024, 256, 1024, 0, 0, -1},
  {(int)WL_WOUT, 1024, 0, 27, 1024, 1024, 1024, 0, 0, -1},
  {(int)WL_WPG, 1024, 0, 29, 1024, 1024, 1024, 0, 0, 28},
};
DI void prep_weights(const Frame& F, LAS unsigned char* lds) {
  LAS float* T = (LAS float*)lds;
  const int tid = otid(), bid = obid(), gdim = ogdim();
  for (int layer = 0; layer < 2; ++layer) {
    for (int j = 0; j < 10; ++j) {
      int dsto, ldd, koff, src, nsrc, K, nrows, kind, base, gain;
      if (j < 9) { dsto = PREP_JOBS[j][0]; ldd = PREP_JOBS[j][1]; koff = PREP_JOBS[j][2]; src = PREP_JOBS[j][3]; nsrc = PREP_JOBS[j][4]; K = PREP_JOBS[j][5]; nrows = PREP_JOBS[j][6]; kind = PREP_JOBS[j][7]; base = PREP_JOBS[j][8]; gain = PREP_JOBS[j][9]; }
      else { dsto = (int)WL_WPROJ; ldd = 256; koff = 0; src = 30; nsrc = 1024; K = 256; nrows = 1024; kind = 0; base = 0; gain = -1; }
      const float* W = F.in(src) + (size_t)layer * K * nsrc;
      const float* gv = gain >= 0 ? F.in(gain) + (size_t)layer * K : nullptr;
      bf16_t* dst = (bf16_t*)(F.W() + WS_W + (size_t)layer * WL_SIZE + dsto);
      const int tk = K / 64, tn = nrows / 64, ntile = tk * tn;
      for (int tix = bid; tix < ntile; tix += gdim) {
        const int n0 = (tix / tk) * 64, k0 = (tix % tk) * 64;
        const int nx = tid & 63, ky0 = tid >> 6;
        const int col = map_col(kind, base, n0 + nx);
        const int colc = col >= 0 ? col : 0; const float mk = col >= 0 ? 1.0f : 0.0f;
        float vals[8];
#pragma unroll
        for (int i = 0; i < 8; ++i) vals[i] = *(const GAS float*)(W + (size_t)(k0 + ky0 + 8 * i) * nsrc + colc);
        if (gv) {
#pragma unroll
          for (int i = 0; i < 8; ++i) vals[i] *= *(const GAS float*)(gv + k0 + ky0 + 8 * i);
        }
#pragma unroll
        for (int i = 0; i < 8; ++i) T[(ky0 + 8 * i) * 65 + nx] = vals[i] * mk;
        __syncthreads();
        const int ny = tid >> 3, ks = (tid & 7) * 8;
        u32x4 w;
        w.x = pk2(T[(ks + 0) * 65 + ny], T[(ks + 1) * 65 + ny]); w.y = pk2(T[(ks + 2) * 65 + ny], T[(ks + 3) * 65 + ny]);
        w.z = pk2(T[(ks + 4) * 65 + ny], T[(ks + 5) * 65 + ny]); w.w = pk2(T[(ks + 6) * 65 + ny], T[(ks + 7) * 65 + ny]);
        *(GAS u32x4*)(dst + (size_t)(n0 + ny) * ldd + koff + k0 + ks) = w;
        __syncthreads();
      }
    }
    {
      bf16_t* dst = (bf16_t*)(F.W() + WS_W + (size_t)layer * WL_SIZE + WL_WPOOL);
      const float* pw = F.in(20) + (size_t)layer * 4 * 64 * 64; const float* ps = F.in(21) + (size_t)layer * 256;
      for (int e = bid * 512 + tid; e < 256 * 256; e += gdim * 512) {
        const int n = e >> 8, k = e & 255;
        float v = 0.f;
        if ((n >> 6) == (k >> 6)) v = pw[((n >> 6) * 64 + (k & 63)) * 64 + (n & 63)] * ps[n];
        dst[e] = (bf16_t)(pk2(v, 0.f) & 0xffffu);
      }
    }
  }
}

DI void prep_misc(const Frame& F) {
  const int tid = otid(), lane = tid & 63, bid = obid(), gdim = ogdim();
  const int gw = bid * 8 + (tid >> 6), nw = gdim * 8;
  bf16_t* XB = (bf16_t*)(F.W() + WS_XB); float* SSQX = (float*)(F.W() + WS_SSQX);
  for (int row = gw; row < MROWS; row += nw) {
    const float* x = row < MP ? F.in(0) + (size_t)row * 1024 : F.in(1) + (size_t)(row - MP) * 1024;
    float s = 0.f;
    f32x4 v4[4];
#pragma unroll
    for (int i = 0; i < 4; ++i) v4[i] = *(const GAS f32x4*)(x + i * 256 + lane * 4);
#pragma unroll
    for (int i = 0; i < 4; ++i) {
      const f32x4 v = v4[i];
      s += ss4(v);
      u32x2 w; w.x = pk2(v[0], v[1]); w.y = pk2(v[2], v[3]);
      *(GAS u32x2*)(XB + (size_t)row * 1024 + i * 256 + lane * 4) = w;
    }
    s = wave_sum(s);
    if (lane < 16) SSQX[(size_t)row * 16 + lane] = lane == 0 ? s : 0.f;
  }
  float* CS = (float*)(F.W() + WS_CS);
  for (int e = bid * 512 + tid; e < 8192 * 16; e += gdim * 512) {
    const int pos = e >> 4, i = e & 15;
    const double inv = exp2(-(double)i * (13.287712379549449 / 16.0));
    double rev = (double)pos * inv * 0.15915494309189535;
    rev -= floor(rev);
    const float fr = (float)rev;
    CS[pos * 32 + i] = __builtin_amdgcn_cosf(fr);
    CS[pos * 32 + 16 + i] = __builtin_amdgcn_sinf(fr);
  }
  bf16_t* KCS = (bf16_t*)(F.W() + WS_KCS); bf16_t* VCTS = (bf16_t*)(F.W() + WS_VCTS);
  for (int e = bid * 512 + tid; e < 2 * 8 * 512 * 256; e += gdim * 512) {
    const int c = e & 255, t = (e >> 8) & 511, lb = e >> 17;
    const float kv = F.in(4)[e], vv = F.in(5)[e];
    KCS[((size_t)lb * CAKS + t) * 256 + c] = (bf16_t)(pk2(kv, 0.f) & 0xffffu);
    VCTS[((size_t)lb * 256 + c) * CAKS + t] = (bf16_t)(pk2(vv, 0.f) & 0xffffu);
  }
}

DI void conv_layer(const Frame& F) {
  const int tid = otid();
  const size_t gt = (size_t)obid() * 512 + tid, gn = (size_t)ogdim() * 512;
  GAS bf16_t* PB = (GAS bf16_t*)(F.W() + WS_PB);
  const GAS float* pp = (const GAS float*)F.in(7) + (size_t)F.layer * MP * 256; const GAS float* psm = (const GAS float*)F.in(8) + (size_t)F.layer * MS * 256;
  for (size_t e0 = gt; e0 < (size_t)MROWS * 64; e0 += 4 * gn) {
    f32x4 v[4];
#pragma unroll
    for (int k = 0; k < 4; ++k) { const size_t e = e0 + k * gn; const size_t row = e >> 6; const int c = (int)(e & 63) * 4;
      v[k] = e < (size_t)MROWS * 64 ? (row < MP ? *(const GAS f32x4*)(pp + row * 256 + c) : *(const GAS f32x4*)(psm + (row - MP) * 256 + c)) : (f32x4){0.f, 0.f, 0.f, 0.f}; }
#pragma unroll
    for (int k = 0; k < 4; ++k) { const size_t e = e0 + k * gn; if (e >= (size_t)MROWS * 64) break; const size_t row = e >> 6; const int c = (int)(e & 63) * 4;
      u32x2 w; w.x = pk2(v[k][0], v[k][1]); w.y = pk2(v[k][2], v[k][3]);
      *(GAS u32x2*)(PB + row * 256 + c) = w; }
  }
  GAS bf16_t* CKVB = (GAS bf16_t*)(F.W() + WS_CKVB); GAS bf16_t* KRB = (GAS bf16_t*)(F.W() + WS_KRB);
  const GAS float* cc = (const GAS float*)F.in(2) + (size_t)F.layer * 8 * PAST * 128; const GAS float* ck = (const GAS float*)F.in(3) + (size_t)F.layer * 8 * PAST * 32;
  for (size_t e0 = gt; e0 < (size_t)8 * PAST * 32; e0 += 4 * gn) {
    f32x4 v[4];
#pragma unroll
    for (int k = 0; k < 4; ++k) { const size_t e = e0 + k * gn; v[k] = e < (size_t)8 * PAST * 32 ? *(const GAS f32x4*)(cc + (e >> 5) * 128 + (int)(e & 31) * 4) : (f32x4){0.f, 0.f, 0.f, 0.f}; }
#pragma unroll
    for (int k = 0; k < 4; ++k) { const size_t e = e0 + k * gn; if (e >= (size_t)8 * PAST * 32) break;
      const size_t tok = e >> 5; const int c = (int)(e & 31) * 4; const size_t b = tok >> 12, t = tok & 4095;
      u32x2 w; w.x = pk2(v[k][0], v[k][1]); w.y = pk2(v[k][2], v[k][3]);
      *(GAS u32x2*)(CKVB + ((size_t)MP + b * TKS + t) * 128 + c) = w; }
  }
  for (size_t e = gt; e < (size_t)8 * PAST * 8; e += gn) {
    const size_t tok = e >> 3; const int c = (int)(e & 7) * 4; const size_t b = tok >> 12, t = tok & 4095;
    const f32x4 v = *(const GAS f32x4*)(ck + tok * 32 + c);
    u32x2 w; w.x = pk2(v[0], v[1]); w.y = pk2(v[2], v[3]);
    *(GAS u32x2*)(KRB + ((size_t)MP + b * TKS + t) * 32 + c) = w;
  }
}

#define FENCE() asm volatile("" ::: "memory")
#define OPAQUE(p) do { asm volatile("" : "+s"(p)); p = GP(p); } while (0)
struct SchedZ {
  const unsigned char* ws; int layer, G, vcu;
  DI bool next(int i, Unit& u) const {
    const int L = i * G + vcu; if (L >= MT * 10 + 24) return false;
    const char* XB = (const char*)(ws + WS_XB); const char* WIN = (const char*)(ws + WS_W + (size_t)layer * WL_SIZE + WL_WIN);
    u.nt = 16;
    if (L >= MT * 10) {
      const int idx = L - MT * 10, tile = idx / 3, gi = idx - tile * 3;
      u.pm = 256 + (tile >> 2); u.pn = tile & 3; u.kind = 10 + gi;
      u.A = XB + (size_t)u.pm * 256 * 2048; u.B = WIN + (size_t)(2560 + gi * 1024 + u.pn * 256) * 2048; return true;
    }
    const int pm = L / 10, k = L % 10;
    u.kind = k;
    if (k < 9) { u.A = XB + (size_t)pm * 256 * 2048; u.B = WIN + (size_t)k * 256 * 2048; u.pm = pm; u.pn = k; }
    else { u.A = WIN + (size_t)2304 * 2048; u.B = XB + (size_t)pm * 256 * 2048; u.pm = 0; u.pn = pm; }
    return true;
  }
};
struct EpiZ {
  const Params* P; int layer;
  template <int kind>
  DI void rows(Acc& acc, const Unit& u, int wr, int wc, int fr, int fq, unsigned char* ws, float* out, const float (&rs8)[8]) const {
    f32x4 gq[2][2] = {};
    if (kind == 6 || kind == 7) {
      const float* gn = GP(kind == 6 ? P->in[23] : P->in[24]) + layer * 64;
#pragma unroll
      for (int bj = 0; bj < 2; ++bj) { gq[bj][0] = *(const GAS f32x4*)(gn + 32 * bj + 8 * fq); gq[bj][1] = *(const GAS f32x4*)(gn + 32 * bj + 8 * fq + 4); }
    }
#pragma unroll
    for (int ai = 0; ai < 2; ++ai)
#pragma unroll
      for (int m = 0; m < 4; ++m) {
        const int row = u.pm * 256 + 128 * ai + 64 * wr + 16 * m + fr;
        const float rs = rs8[ai * 4 + m];
        f32x4 v[2][2];
#pragma unroll
        for (int bj = 0; bj < 2; ++bj)
#pragma unroll
          for (int n = 0; n < 2; ++n) v[bj][n] = acc[ai][bj][m][n] * rs;
        const int cl0 = 32 * wc + 8 * fq;
        if (kind == 0) {
          bf16_t* HQ = (bf16_t*)(ws + WS_G1 + G1_HQ); float* SSQQ = (float*)(ws + WS_SSQQ);
          float s = (ss4(v[0][0]) + ss4(v[0][1])) + (ss4(v[1][0]) + ss4(v[1][1]));
          s = red_fq(s);
          if (fq == 0) *(GAS float*)(SSQQ + (size_t)row * 4 + wc) = s;
#pragma unroll
          for (int bj = 0; bj < 2; ++bj) *(GAS u32x4*)(HQ + (size_t)row * 256 + 128 * bj + cl0) = pack8(v[bj][0], v[bj][1]);
        } else if (kind == 1) {
          float* HKV = (float*)(ws + WS_G1 + G1_HKV);
          *(GAS f32x4*)(HKV + (size_t)row * 160 + cl0) = v[0][0]; *(GAS f32x4*)(HKV + (size_t)row * 160 + cl0 + 4) = v[0][1];
          if (wc == 0) { *(GAS f32x4*)(HKV + (size_t)row * 160 + 128 + cl0) = v[1][0]; *(GAS f32x4*)(HKV + (size_t)row * 160 + 128 + cl0 + 4) = v[1][1]; }
        } else if (kind == 2 || kind == 3 || kind == 5 || kind == 8) {
          bf16_t* dst = kind == 5 ? (bf16_t*)(ws + WS_GB) + (size_t)row * 256 : kind == 8 ? (bf16_t*)(ws + WS_G1 + G1_GC) + (size_t)row * 256 : (bf16_t*)(ws + WS_R2 + R2_GA) + (size_t)row * 512 + (kind - 2) * 256;
#pragma unroll
          for (int bj = 0; bj < 2; ++bj) {
            f32x4 a = v[bj][0], b = v[bj][1];
#pragma unroll
            for (int q = 0; q < 4; ++q) { a[q] = siluf_(a[q]); b[q] = siluf_(b[q]); }
            *(GAS u32x4*)(dst + 128 * bj + cl0) = pack8(a, b);
          }
        } else if (kind == 4) {
          bf16_t* UB = (bf16_t*)(ws + WS_G1 + G1_UB);
#pragma unroll
          for (int bj = 0; bj < 2; ++bj) *(GAS u32x4*)(UB + (size_t)row * 256 + 128 * bj + cl0) = pack8(v[bj][0], v[bj][1]);
          float* o = nullptr;
          if (row < MP) { const int t = row & 8191; if (t >= 8177) o = out + O_PLP + (((size_t)layer * 8 + (row >> 13)) * 15 + (t - 8177)) * 256; }
          else { const int rsm = row - MP, t = rsm & 63; if (t >= 49) o = out + O_PLS + (((size_t)layer * 8 + (rsm >> 6)) * 15 + (t - 49)) * 256; }
          if (o) {
#pragma unroll
            for (int bj = 0; bj < 2; ++bj) { *(GAS f32x4*)(o + 128 * bj + cl0) = v[bj][0]; *(GAS f32x4*)(o + 128 * bj + cl0 + 4) = v[bj][1]; }
          }
        } else {
          float s = (ss4(v[0][0]) + ss4(v[0][1])) + (ss4(v[1][0]) + ss4(v[1][1]));
          s = red_fq(s);
          const float r2 = __builtin_amdgcn_rsqf(s * (1.0f / 64.0f) + EPSF) * (kind == 6 ? QSCALE_CA : 1.0f);
#pragma unroll
          for (int bj = 0; bj < 2; ++bj) {
            const int e0 = 32 * bj + 8 * fq;
            const f32x4 g0 = gq[bj][0], g1 = gq[bj][1];
            const f32x4 a = v[bj][0] * g0 * r2, b = v[bj][1] * g1 * r2;
            const u32x4 w = pack8(a, b);
            if (kind == 6) *(GAS u32x4*)((bf16_t*)(ws + WS_G1 + G1_QC) + (size_t)row * 256 + wc * 64 + e0) = w;
            else {
              if (row < MP) {
                *(GAS u32x4*)((bf16_t*)(ws + WS_G1 + G1_KC) + (size_t)row * 256 + wc * 64 + e0) = w;
                const int t = row & 8191;
                if (t >= 7680) { float* o = out + O_CKP + (((size_t)layer * 8 + (row >> 13)) * 512 + (t - 7680)) * 256 + wc * 64 + e0; *(GAS f32x4*)o = a; *(GAS f32x4*)(o + 4) = b; }
              } else {
                const int rsm = row - MP, b_ = rsm >> 6, t = rsm & 63;
                *(GAS u32x4*)((bf16_t*)(ws + WS_KCS) + (((size_t)layer * 8 + b_) * CAKS + 512 + t) * 256 + wc * 64 + e0) = w;
                float* o = out + O_CKS + (((size_t)layer * 8 + b_) * 64 + t) * 256 + wc * 64 + e0; *(GAS f32x4*)o = a; *(GAS f32x4*)(o + 4) = b;
              }
            }
          }
        }
        FENCE();
      }
  }
  DI void operator()(Acc& acc, const Unit& u, int wr, int wc, int fr, int fq) const {
    const int kind = u.kind;
    unsigned char* ws = P->ws; float* out = P->out; OPAQUE(ws); OPAQUE(out);
    const float* SSQX = (const float*)(ws + WS_SSQX);
    if (kind == 9) {
      const int j = u.pn;
      bf16_t* VCT = (bf16_t*)(ws + WS_G1 + G1_VCT); bf16_t* VCTSl = (bf16_t*)(ws + WS_VCTS) + (size_t)layer * 8 * 256 * CAKS;
#pragma unroll
      for (int bj = 0; bj < 2; ++bj) {
        const int tl = 128 * bj + 32 * wc + 8 * fq;
        const int tok = 256 * j + tl;
        float rs[8];
#pragma unroll
        for (int q = 0; q < 8; ++q) rs[q] = *(const GAS float*)(SSQX + (size_t)(tok + q) * 16 + fr);
#pragma unroll
        for (int q = 0; q < 8; ++q) { float t = rs[q]; t += swz_xor<1>(t); t += swz_xor<2>(t); t += swz_xor<4>(t); t += swz_xor<8>(t); rs[q] = __builtin_amdgcn_rsqf(t * (1.0f / 1024.0f) + EPSF); }
#pragma unroll
        for (int ai = 0; ai < 2; ++ai)
#pragma unroll
          for (int m = 0; m < 4; ++m) {
            const int hd = 128 * ai + 64 * wr + 16 * m + fr;
            f32x4 v0 = acc[ai][bj][m][0], v1 = acc[ai][bj][m][1];
#pragma unroll
            for (int q = 0; q < 4; ++q) { v0[q] *= rs[q]; v1[q] *= rs[4 + q]; }
            const u32x4 w = pack8(v0, v1);
            if (j < 256) {
              const int b = j >> 5, t = tok & 8191;
              *(GAS u32x4*)(VCT + ((size_t)(b * 256 + hd)) * 8192 + t) = w;
              if (t >= 7680) {
                float* o = out + O_CVP + (((size_t)layer * 8 + b) * 512 + (t - 7680)) * 256 + hd;
#pragma unroll
                for (int q = 0; q < 4; ++q) { *(GAS float*)(o + (size_t)q * 256) = v0[q]; *(GAS float*)(o + (size_t)(4 + q) * 256) = v1[q]; }
              }
            } else {
              const int ts = tok - MP, b = ts >> 6, t = ts & 63;
              *(GAS u32x4*)(VCTSl + ((size_t)(b * 256 + hd)) * CAKS + 512 + t) = w;
              float* o = out + O_CVS + (((size_t)layer * 8 + b) * 64 + t) * 256 + hd;
#pragma unroll
              for (int q = 0; q < 4; ++q) { *(GAS float*)(o + (size_t)q * 256) = v0[q]; *(GAS float*)(o + (size_t)(4 + q) * 256) = v1[q]; }
            }
            FENCE();
          }
      }
      return;
    }
    float rs8[8];
    rstd8(SSQX, u.pm * 256 + 64 * wr + fr, fq, 1.0f / 1024.0f, rs8);
    if (kind >= 10) {
      bf16_t* GMS = (bf16_t*)(ws + WS_GMS);
#pragma unroll
      for (int ai = 0; ai < 2; ++ai)
#pragma unroll
        for (int m = 0; m < 4; ++m) {
          const int rsm = (u.pm - 256) * 256 + 128 * ai + 64 * wr + 16 * m + fr;
#pragma unroll
          for (int bj = 0; bj < 2; ++bj) {
            f32x4 a = acc[ai][bj][m][0] * rs8[ai * 4 + m], b = acc[ai][bj][m][1] * rs8[ai * 4 + m];
#pragma unroll
            for (int q = 0; q < 4; ++q) { a[q] = sigmoidf_(a[q]); b[q] = sigmoidf_(b[q]); }
            *(GAS u32x4*)(GMS + (size_t)rsm * 3072 + (kind - 10) * 1024 + u.pn * 256 + 128 * bj + 32 * wc + 8 * fq) = pack8(a, b);
          }
          FENCE();
        }
      return;
    }
    switch (kind) {
      case 0: rows<0>(acc, u, wr, wc, fr, fq, ws, out, rs8); break;
      case 1: rows<1>(acc, u, wr, wc, fr, fq, ws, out, rs8); break;
      case 2: rows<2>(acc, u, wr, wc, fr, fq, ws, out, rs8); break;
      case 3: rows<3>(acc, u, wr, wc, fr, fq, ws, out, rs8); break;
      case 4: rows<4>(acc, u, wr, wc, fr, fq, ws, out, rs8); break;
      case 5: rows<5>(acc, u, wr, wc, fr, fq, ws, out, rs8); break;
      case 6: rows<6>(acc, u, wr, wc, fr, fq, ws, out, rs8); break;
      case 7: rows<7>(acc, u, wr, wc, fr, fq, ws, out, rs8); break;
      default: rows<8>(acc, u, wr, wc, fr, fq, ws, out, rs8); break;
    }
  }
};

struct SchedQ {
  const unsigned char* ws; int layer, G, vcu;
  DI bool next(int i, Unit& u) const {
    int L = i * G + vcu; if (L >= MT * 3 * DUP_Q) return false;
    L %= MT * 3;
    u.pm = L / 3; u.pn = L % 3; u.kind = u.pn; u.nt = 4;
    u.A = (const char*)(ws + WS_G1 + G1_HQ) + (size_t)u.pm * 256 * 512; u.B = (const char*)(ws + WS_W + (size_t)layer * WL_SIZE + WL_WUQ) + (size_t)u.pn * 256 * 512; return true;
  }
};
struct EpiQ {
  const Params* P; int layer;
  DI void operator()(Acc& acc, const Unit& u, int wr, int wc, int fr, int fq) const {
    unsigned char* ws = P->ws; OPAQUE(ws);
    const float* SSQQ = (const float*)(ws + WS_SSQQ); bf16_t* QP = (bf16_t*)(ws + WS_R2 + R2_QP);
    float rs8[8];
#pragma unroll
    for (int k = 0; k < 8; ++k) rs8[k] = *(const GAS float*)(SSQQ + (size_t)(u.pm * 256 + 128 * (k >> 2) + 64 * wr + 16 * (k & 3) + fr) * 4 + fq);
#pragma unroll
    for (int k = 0; k < 8; ++k) rs8[k] = __builtin_amdgcn_rsqf(red_fq(rs8[k]) * (1.0f / 256.0f) + EPSF);
#pragma unroll
    for (int ai = 0; ai < 2; ++ai)
#pragma unroll
      for (int m = 0; m < 4; ++m) {
        const int row = u.pm * 256 + 128 * ai + 64 * wr + 16 * m + fr;
        const float rs = rs8[ai * 4 + m];
        f32x4 v[2][2];
#pragma unroll
        for (int bj = 0; bj < 2; ++bj)
#pragma unroll
          for (int n = 0; n < 2; ++n) v[bj][n] = acc[ai][bj][m][n] * rs;
        if (u.kind < 2) {
          const float* qn_nope = GP(P->in[15]) + layer * 64;
          const int head = 4 * u.pn + wc;
          float s = (ss4(v[0][0]) + ss4(v[0][1])) + (ss4(v[1][0]) + ss4(v[1][1]));
          s = red_fq(s);
          const float r2 = __builtin_amdgcn_rsqf(s * (1.0f / 64.0f) + EPSF) * QSCALE_MLA;
#pragma unroll
          for (int bj = 0; bj < 2; ++bj) {
            const int e0 = 32 * bj + 8 * fq;
            const f32x4 g0 = *(const GAS f32x4*)(qn_nope + e0), g1 = *(const GAS f32x4*)(qn_nope + e0 + 4);
            *(GAS u32x4*)(QP + (size_t)row * 768 + head * 96 + e0) = pack8(v[bj][0] * g0 * r2, v[bj][1] * g1 * r2);
          }
        } else {
          const float* qn_rope = GP(P->in[16]) + layer * 32; const float* CS = (const float*)(ws + WS_CS);
          const int pos = row < MP ? (row & 8191) : PAST + ((row - MP) & 63);
          const int i0 = 8 * (fq & 1);
          const f32x4 c0 = *(const GAS f32x4*)(CS + pos * 32 + i0), c1 = *(const GAS f32x4*)(CS + pos * 32 + i0 + 4);
          const f32x4 s0 = *(const GAS f32x4*)(CS + pos * 32 + 16 + i0), s1 = *(const GAS f32x4*)(CS + pos * 32 + 16 + i0 + 4);
          const f32x4 g0 = *(const GAS f32x4*)(qn_rope + 8 * fq), g1 = *(const GAS f32x4*)(qn_rope + 8 * fq + 4);
          const float sg = fq < 2 ? -1.0f : 1.0f;
#pragma unroll
          for (int bj = 0; bj < 2; ++bj) {
            const int head = 2 * wc + bj;
            float s = ss4(v[bj][0]) + ss4(v[bj][1]);
            s = red_fq(s);
            const float r2 = __builtin_amdgcn_rsqf(s * (1.0f / 32.0f) + EPSF);
            f32x4 y0 = v[bj][0] * g0 * r2, y1 = v[bj][1] * g1 * r2, o0, o1;
#pragma unroll
            for (int q = 0; q < 4; ++q) {
              const float p0 = get_xor32(y0[q], fq >= 2), p1 = get_xor32(y1[q], fq >= 2);
              o0[q] = (y0[q] * c0[q] + sg * p0 * s0[q]) * QSCALE_MLA;
              o1[q] = (y1[q] * c1[q] + sg * p1 * s1[q]) * QSCALE_MLA;
            }
            *(GAS u32x4*)(QP + (size_t)row * 768 + head * 96 + 64 + 8 * fq) = pack8(o0, o1);
          }
        }
        FENCE();
      }
  }
};

DI void post_kv(const Frame& F) {
  const int tid = otid(), lane = tid & 63;
  const int gw = obid() * 8 + (tid >> 6), nw = ogdim() * 8;
  const GAS float* HKV = (const GAS float*)F.g1(G1_HKV); const GAS float* CS = (const GAS float*)(F.W() + WS_CS);
  const GAS float* kvn = (const GAS float*)F.lin(13, 128); const GAS float* knr = (const GAS float*)F.lin(18, 32);
  GAS bf16_t* CKVB = (GAS bf16_t*)(F.W() + WS_CKVB); GAS bf16_t* KRB = (GAS bf16_t*)(F.W() + WS_KRB);
  GAS float* out = (GAS float*)F.O();
  const f32x2 g = *(const GAS f32x2*)(kvn + 2 * lane);
  const float gr = knr[lane & 31];
  for (int row0 = gw; row0 < MROWS; row0 += 4 * nw) {
    f32x2 v[4]; float kr[4], csv[4], snv[4];
#pragma unroll
    for (int k = 0; k < 4; ++k) { const int row = row0 + k * nw; const bool ok = row < MROWS; const size_t rr = ok ? row : 0;
      const int pos_ = rr < (size_t)MP ? (int)(rr & 8191) : PAST + (int)((rr - MP) & 63);
      v[k] = *(const GAS f32x2*)(HKV + rr * 160 + 2 * lane); kr[k] = HKV[rr * 160 + 128 + (lane & 31)];
      csv[k] = CS[pos_ * 32 + (lane & 15)]; snv[k] = CS[pos_ * 32 + 16 + (lane & 15)]; }
#pragma unroll
    for (int k = 0; k < 4; ++k) kr[k] = lane < 32 ? kr[k] : 0.f;
#pragma unroll
    for (int k = 0; k < 4; ++k) {
      const int row = row0 + k * nw; if (row >= MROWS) break;
      const float sc = wave_sum(v[k][0] * v[k][0] + v[k][1] * v[k][1]);
      const float sr = wave_sum(kr[k] * kr[k]);
      const float rc = __builtin_amdgcn_rsqf(sc * (1.0f / 128.0f) + EPSF), rr = __builtin_amdgcn_rsqf(sr * (1.0f / 32.0f) + EPSF);
      const f32x2 c = {v[k][0] * rc * g[0], v[k][1] * rc * g[1]};
      int pos; size_t R; GAS float* oc; GAS float* ok;
      if (row < MP) { pos = row & 8191; R = row; oc = out + O_CKVP + ((size_t)F.layer * MP + row) * 128; ok = out + O_KRP + ((size_t)F.layer * MP + row) * 32; }
      else { const int rsm = row - MP, b = rsm >> 6, t = rsm & 63; pos = PAST + t; R = (size_t)MP + (size_t)b * TKS + PAST + t;
             oc = out + O_CKVS + ((size_t)F.layer * MS + rsm) * 128; ok = out + O_KRS + ((size_t)F.layer * MS + rsm) * 32; }
      *(GAS f32x2*)(oc + 2 * lane) = c;
      *(GAS unsigned*)(CKVB + R * 128 + 2 * lane) = pk2(c[0], c[1]);
      const float y = kr[k] * rr * gr;
      const float p = swz_xor<16>(y);
      const int idx = lane & 15;
      const float cs = csv[k], sn = snv[k]; (void)idx; (void)pos;
      const float o = y * cs + ((lane & 16) ? p : -p) * sn;
      if (lane < 32) { ok[lane] = o; KRB[R * 32 + lane] = (bf16_t)(pk2(o, 0.f) & 0xffffu); }
    }
  }
}

DI void pooled_rows(const Frame& F) {
  const int tid = otid(), lane = tid & 63;
  const int gw = obid() * 8 + (tid >> 6), nw = ogdim() * 8;
  const GAS bf16_t* UB = (const GAS bf16_t*)F.g1(G1_UB); GAS bf16_t* PO = (GAS bf16_t*)(F.W() + WS_POOLED);
  const GAS float* hist = (const GAS float*)F.lin(6, 8 * 15 * 256);
  const int w = 2 << (lane >> 4), c = 4 * lane;
  for (int row = gw; row < MROWS; row += nw) {
    f32x4 s = {0.f, 0.f, 0.f, 0.f}, u0 = s; float cnt;
    if (row < MP) {
      const int t = row & 8191; cnt = (float)(t + 1 < w ? t + 1 : w);
      u32x2 x[16];
#pragma unroll
      for (int j = 0; j < 16; ++j) { const bool ok = j < w && j <= t; x[j] = *(const GAS u32x2*)(UB + (size_t)(ok ? row - j : row) * 256 + c); }
#pragma unroll
      for (int j = 0; j < 16; ++j) {
        const bool ok = j < w && j <= t;
        const f32x4 f = {bflo(x[j].x), bfhi(x[j].x), bflo(x[j].y), bfhi(x[j].y)};
        if (j == 0) u0 = f;
        const float mk = ok ? 1.0f : 0.0f;
        s += f * mk;
      }
    } else {
      const int rsm = row - MP, b = rsm >> 6, t = rsm & 63; cnt = (float)w;
      for (int j = 0; j < 16; ++j) if (j < w) {
        f32x4 f;
        if (j <= t) { const u32x2 x = *(const GAS u32x2*)(UB + (size_t)(row - j) * 256 + c); f = (f32x4){bflo(x.x), bfhi(x.x), bflo(x.y), bfhi(x.y)}; }
        else f = *(const GAS f32x4*)(hist + ((size_t)b * 15 + (15 + t - j)) * 256 + c);
        s += f; if (j == 0) u0 = f; }
    }
    const float ic = 1.0f / cnt;
    const f32x4 p = s * ic - u0;
    u32x2 wv; wv.x = pk2(p[0], p[1]); wv.y = pk2(p[2], p[3]);
    *(GAS u32x2*)(PO + (size_t)row * 256 + c) = wv;
  }
}

template <int DQK, bool BIAS, bool PARTIAL>
DI void attn_unit(LAS unsigned char* lds, const bf16_t* Qw, int qpitch, const bf16_t* Kb, int kpitch, const bf16_t* Vt, int vpitch,
                  int t_begin, int t_end, int w_lo, int w_hi, bool active,
                  const float* btab_g, int kpos0, int qpos_w,
                  const bf16_t* gate, int gpitch, bf16_t* outp  , float* part  ) {
  constexpr int KS = DQK / 16, KPB = DQK * 2 + 16, KTILE = 64 * KPB, VPB = 136, VTILE = 64 * VPB, SEG = DQK / 8, NPK = 64 * SEG;
  constexpr int OFF_K = 0, OFF_V = 2 * KTILE, OFF_BT = OFF_V + 2 * VTILE;
  const int tid = otid(), lane = tid & 63, r = lane & 31, h = lane >> 5;
  LAS float* bt = (LAS float*)(lds + OFF_BT);
  const int p1 = (tid + 512) < NPK ? tid + 512 : tid;
  const int kr0 = tid / SEG, ks0 = tid % SEG, kr1 = p1 / SEG, ks1 = p1 % SEG;
  const int vd = tid >> 3, vs = tid & 7;
  const bf16_t* kp0 = Kb + (size_t)kr0 * kpitch + 8 * ks0; const bf16_t* kp1 = Kb + (size_t)kr1 * kpitch + 8 * ks1; const bf16_t* vp0 = Vt + (size_t)vd * vpitch + 8 * vs;
  const int lk0 = OFF_K + kr0 * KPB + ks0 * 16, lk1 = OFF_K + kr1 * KPB + ks1 * 16, lv0 = OFF_V + vd * VPB + vs * 16;
  u32x4 ak0, ak1 = {0, 0, 0, 0}, av, bk0, bk1 = {0, 0, 0, 0}, bv;
#define AT_GLOAD(K0, K1, V, t) do { const int tt_ = (t) < t_end ? (t) : t_end - 1; K0 = *(const GAS u32x4*)(kp0 + (size_t)tt_ * 64 * kpitch); if (NPK > 512) K1 = *(const GAS u32x4*)(kp1 + (size_t)tt_ * 64 * kpitch); V = *(const GAS u32x4*)(vp0 + 64 * tt_); } while (0)
#define AT_LSTORE(K0, K1, V, buf) do { *(LAS u32x4*)(lds + (buf) * KTILE + lk0) = K0; if (NPK > 512) *(LAS u32x4*)(lds + (buf) * KTILE + lk1) = K1; \
    *(LAS u32x2*)(lds + (buf) * VTILE + lv0) = (u32x2){V.x, V.y}; *(LAS u32x2*)(lds + (buf) * VTILE + lv0 + 8) = (u32x2){V.z, V.w}; } while (0)
  if ((__builtin_amdgcn_readfirstlane(tid >> 6) >> 2) != 0) __builtin_amdgcn_s_setprio(1);
  AT_GLOAD(ak0, ak1, av, t_begin);
  AT_GLOAD(bk0, bk1, bv, t_begin + 1);
  if (BIAS) { if (tid < 257) bt[tid] = ((const GAS float*)btab_g)[tid] * LOG2E; }
  bf16x8 qr[KS];
  if (active) {
#pragma unroll
    for (int s = 0; s < KS; ++s) qr[s] = *(const GAS bf16x8*)(Qw + (size_t)r * qpitch + 16 * s + 8 * h);
  } else {
#pragma unroll
    for (int s = 0; s < KS; ++s) qr[s] = (bf16x8){0, 0, 0, 0, 0, 0, 0, 0};
  }
  AT_LSTORE(ak0, ak1, av, 0);
  __syncthreads();
  float mrun = 0.0f;
  const f32x16 z16 = {0.f, 0.f, 0.f, 0.f, 0.f, 0.f, 0.f, 0.f, 0.f, 0.f, 0.f, 0.f, 0.f, 0.f, 0.f, 0.f};
  f32x16 o0 = z16, o1 = z16, negm = z16 - mrun;
  float lq0 = 0.f, lq1 = 0.f;
  auto compute = [&](int t, int buf) {
    const LAS unsigned char* kb = lds + OFF_K + buf * KTILE + r * KPB + h * 16;
    const LAS unsigned char* vb = lds + OFF_V + buf * VTILE + r * VPB + h * 8;
    f32x16 s0, s1;
    bf16x8 kf[2 * KS];
#pragma unroll
    for (int s = 0; s < KS; ++s) { kf[2 * s] = *(const LAS bf16x8*)(kb + s * 32); kf[2 * s + 1] = *(const LAS bf16x8*)(kb + 32 * KPB + s * 32); }
    __builtin_amdgcn_sched_barrier(0);
    s0 = __builtin_amdgcn_mfma_f32_32x32x16_bf16(kf[0], qr[0], negm, 0, 0, 0); s1 = __builtin_amdgcn_mfma_f32_32x32x16_bf16(kf[1], qr[0], negm, 0, 0, 0);
#pragma unroll
    for (int s = 1; s < KS; ++s) {
      s0 = __builtin_amdgcn_mfma_f32_32x32x16_bf16(kf[2 * s], qr[s], s0, 0, 0, 0);
      s1 = __builtin_amdgcn_mfma_f32_32x32x16_bf16(kf[2 * s + 1], qr[s], s1, 0, 0, 0);
    }
    u32x2 vf[16];
#pragma unroll
    for (int s2 = 0; s2 < 4; ++s2) {
      const int kvo = (32 * (s2 >> 1) + 16 * (s2 & 1)) * 2;
      vf[4 * s2] = *(const LAS u32x2*)(vb + kvo); vf[4 * s2 + 1] = *(const LAS u32x2*)(vb + kvo + 16);
      vf[4 * s2 + 2] = *(const LAS u32x2*)(vb + 32 * VPB + kvo); vf[4 * s2 + 3] = *(const LAS u32x2*)(vb + 32 * VPB + kvo + 16);
    }
    __builtin_amdgcn_sched_barrier(0);
    if (BIAS) {
      const int dlt = kpos0 + 64 * t - (qpos_w + r) + 4 * h;
      if (kpos0 + 64 * t + 63 - qpos_w <= -128) {
        const float bc = bt[0];
        s0 = s0 + bc; s1 = s1 + bc;
      } else {
#pragma unroll
        for (int i = 0; i < 16; ++i) {
          const int d0 = dlt + (i & 3) + 8 * (i >> 2), d1 = d0 + 32;
          const int i0 = (d0 < -128 ? -128 : (d0 > 128 ? 128 : d0)) + 128, i1 = (d1 < -128 ? -128 : (d1 > 128 ? 128 : d1)) + 128;
          s0[i] += bt[i0]; s1[i] += bt[i1];
        }
      }
    }
    float mx = fmaxf(fmaxf(s0[0], s0[1]), s1[0]), my = fmaxf(fmaxf(s0[2], s0[3]), s1[1]);
    mx = fmaxf(fmaxf(mx, s1[2]), s1[3]);
#pragma unroll
    for (int i = 4; i < 16; i += 4) { mx = fmaxf(fmaxf(mx, s0[i]), s0[i + 1]); my = fmaxf(fmaxf(my, s0[i + 2]), s0[i + 3]); mx = fmaxf(fmaxf(mx, s1[i]), s1[i + 1]); my = fmaxf(fmaxf(my, s1[i + 2]), s1[i + 3]); }
    mx = max_xor32(fmaxf(mx, my));
    if (__builtin_amdgcn_ballot_w64(mx > 0.0f) != 0ull) {
      const float dl = fmaxf(mx, 0.0f);
      const float alpha = __builtin_amdgcn_exp2f(-dl);
      mrun += dl;
      o0 = o0 * alpha; o1 = o1 * alpha; lq0 *= alpha; lq1 *= alpha;
      s0 = s0 - dl; s1 = s1 - dl; negm = z16 - mrun;
    }
#pragma unroll
    for (int s2 = 0; s2 < 4; ++s2) {
      const int b8 = 8 * (s2 & 1);
      float e[8];
#pragma unroll
      for (int i = 0; i < 8; ++i) e[i] = __builtin_amdgcn_exp2f(s2 < 2 ? s0[b8 + i] : s1[b8 + i]);
#pragma unroll
      for (int i = 0; i < 8; ++i) { if (i & 1) lq1 += e[i]; else lq0 += e[i]; }
      u32x4 w; w.x = pk2(e[0], e[1]); w.y = pk2(e[2], e[3]); w.z = pk2(e[4], e[5]); w.w = pk2(e[6], e[7]);
      const bf16x8 pbs = __builtin_bit_cast(bf16x8, w);
      const bf16x8 va0 = __builtin_bit_cast(bf16x8, (u32x4){vf[4 * s2].x, vf[4 * s2].y, vf[4 * s2 + 1].x, vf[4 * s2 + 1].y});
      const bf16x8 va1 = __builtin_bit_cast(bf16x8, (u32x4){vf[4 * s2 + 2].x, vf[4 * s2 + 2].y, vf[4 * s2 + 3].x, vf[4 * s2 + 3].y});
      __builtin_amdgcn_sched_barrier(0);
      o0 = __builtin_amdgcn_mfma_f32_32x32x16_bf16(va0, pbs, o0, 0, 0, 0);
      o1 = __builtin_amdgcn_mfma_f32_32x32x16_bf16(va1, pbs, o1, 0, 0, 0);
      __builtin_amdgcn_sched_barrier(0);
    }
  };
  for (int t = t_begin; t < t_end; t += 2) {
    AT_GLOAD(ak0, ak1, av, t + 2);
    if (active && t >= w_lo && t <= w_hi) compute(t, 0);
    AT_LSTORE(bk0, bk1, bv, 1);
    __syncthreads();
    AT_GLOAD(bk0, bk1, bv, t + 3);
    if (active && t + 1 >= w_lo && t + 1 <= w_hi && t + 1 < t_end) compute(t + 1, 1);
    AT_LSTORE(ak0, ak1, av, 0);
    __syncthreads();
  }
#undef AT_GLOAD
#undef AT_LSTORE
  __builtin_amdgcn_s_setprio(0);
  if (active) {
    const float ll = lq0 + lq1;
    const float lt = sum_xor32(ll);
    if (PARTIAL) {
      float* pp = part + (size_t)r * 66;
      if (h == 0) { pp[0] = mrun; pp[1] = lt; }
#pragma unroll
      for (int db = 0; db < 2; ++db)
#pragma unroll
        for (int g4 = 0; g4 < 4; ++g4) {
          const int d0 = 32 * db + 8 * g4 + 4 * h;
          f32x2 x0 = {db ? o1[4 * g4] : o0[4 * g4], db ? o1[4 * g4 + 1] : o0[4 * g4 + 1]}, x1 = {db ? o1[4 * g4 + 2] : o0[4 * g4 + 2], db ? o1[4 * g4 + 3] : o0[4 * g4 + 3]};
          *(GAS f32x2*)(pp + 2 + d0) = x0; *(GAS f32x2*)(pp + 4 + d0) = x1;
        }
    } else {
      const float il = 1.0f / lt;
      const bf16_t* gp = gate + (size_t)r * gpitch; bf16_t* op = outp + (size_t)r * 1024;
      u32x2 gg8[8];
#pragma unroll
      for (int k = 0; k < 8; ++k) gg8[k] = *(const GAS u32x2*)(gp + 32 * (k >> 2) + 8 * (k & 3) + 4 * h);
#pragma unroll
      for (int db = 0; db < 2; ++db)
#pragma unroll
        for (int g4 = 0; g4 < 4; ++g4) {
          const int d0 = 32 * db + 8 * g4 + 4 * h;
          const u32x2 gg = gg8[db * 4 + g4];
          const float a = (db ? o1[4 * g4] : o0[4 * g4]) * il * bflo(gg.x), b = (db ? o1[4 * g4 + 1] : o0[4 * g4 + 1]) * il * bfhi(gg.x);
          const float c = (db ? o1[4 * g4 + 2] : o0[4 * g4 + 2]) * il * bflo(gg.y), d = (db ? o1[4 * g4 + 3] : o0[4 * g4 + 3]) * il * bfhi(gg.y);
          u32x2 w; w.x = pk2(a, b); w.y = pk2(c, d);
          *(GAS u32x2*)(op + d0) = w;
        }
    }
  }
}

DI void ca_phase(const Frame& F, LAS unsigned char* lds) {
  const int wid = __builtin_amdgcn_readfirstlane(otid() >> 6);
  const bf16_t* QC = (const bf16_t*)F.g1(G1_QC); const bf16_t* KC = (const bf16_t*)F.g1(G1_KC); const bf16_t* VCT = (const bf16_t*)F.g1(G1_VCT);
  const bf16_t* GC = (const bf16_t*)F.g1(G1_GC); bf16_t* OC = (bf16_t*)(F.W() + WS_OCAT);
  const bf16_t* KCSl = (const bf16_t*)(F.W() + WS_KCS) + (size_t)F.layer * 8 * CAKS * 256;
  const bf16_t* VCTSl = (const bf16_t*)(F.W() + WS_VCTS) + (size_t)F.layer * 8 * 256 * CAKS;
  const float* rel = F.lin(25, 4 * 257);
  const int NU = 8 * 4 * 32 + 32;
  for (int it = 0;; ++it) {
    int L = it * F.G + F.vcu; if (L >= NU * DUP_CA) break;
    L %= NU;
    if (L < 1024) {
      const int g = 31 - (L >> 5), bh = L & 31, b = bh >> 2, hh = bh & 3;
      const int c = 4 * g + (wid >> 1);
      const size_t row0 = (size_t)b * 8192 + 256 * g + 32 * wid;
      const int tb = 4 * g - 8 < 0 ? 0 : 4 * g - 8;
      attn_unit<64, true, false>(lds, QC + row0 * 256 + hh * 64, 256, KC + (size_t)b * 8192 * 256 + hh * 64, 256, VCT + ((size_t)b * 256 + hh * 64) * 8192, 8192,
                          tb, 4 * g + 4, c - 8 < 0 ? 0 : c - 8, c, true, rel + hh * 257, 0, 256 * g + 32 * wid,
                          GC + row0 * 256 + hh * 64, 256, OC + row0 * 1024 + 768 + hh * 64, nullptr);
    } else {
      const int bh = L - 1024, b = bh >> 2, hh = bh & 3;
      const size_t row0 = (size_t)MP + b * 64 + 32 * (wid & 1);
      attn_unit<64, true, false>(lds, QC + row0 * 256 + hh * 64, 256, KCSl + (size_t)b * CAKS * 256 + hh * 64, 256, VCTSl + ((size_t)b * 256 + hh * 64) * CAKS, CAKS,
                          0, 9, 0, 8, wid < 2, rel + hh * 257, PAST - 512, PAST + 32 * (wid & 1),
                          GC + row0 * 256 + hh * 64, 256, OC + row0 * 1024 + 768 + hh * 64, nullptr);
    }
  }
}

DI void mla_phase(const Frame& F, LAS unsigned char* lds) {
  const int wid = __builtin_amdgcn_readfirstlane(otid() >> 6);
  const bf16_t* QP = (const bf16_t*)F.r2(R2_QP); const bf16_t* GA = (const bf16_t*)F.r2(R2_GA);
  const bf16_t* KP = (const bf16_t*)F.g1(G1_KP); const bf16_t* KPS = (const bf16_t*)F.g1(G1_KPS);
  const bf16_t* VT = (const bf16_t*)F.g1(G1_VT); const bf16_t* VTS = (const bf16_t*)F.g1(G1_VTS);
  bf16_t* OC = (bf16_t*)(F.W() + WS_OCAT); float* PART = (float*)(F.W() + WS_PART);
  const int NU = 2048 + 256;
  for (int it = 0;; ++it) {
    int L;
    if (F.G == 256) {
      const int x = F.vcu >> 5, jj = F.vcu & 31;
      if (it < 8) { const int bh = x * 8 + it, qb = (it & 1) ? 31 - jj : jj; L = -1 - (bh * 32 + qb); }
      else if (it == 8) L = 2048 + F.vcu; else break;
    } else { L = it * F.G + F.vcu; if (L >= NU) break; if (L < 2048) { const int qb = 31 - (L >> 6), bh = L & 63; L = -1 - (bh * 32 + qb); } }
    if (L < 0) {
      const int code = -1 - L, bh = code >> 5, qb = code & 31, b = bh >> 3, hh = bh & 7;
      const size_t row0 = (size_t)b * 8192 + 256 * qb + 32 * wid;
      attn_unit<96, false, false>(lds, QP + row0 * 768 + hh * 96, 768, KP + (size_t)bh * 8192 * 96, 96, VT + ((size_t)b * 512 + hh * 64) * 8192, 8192,
                                  0, 4 * qb + 4, 0, 4 * qb + (wid >> 1), true, nullptr, 0, 0,
                                  GA + row0 * 512 + hh * 64, 512, OC + row0 * 1024 + hh * 64, nullptr);
    } else {
      const int su = L - 2048, bh = su >> 2, qt = su & 3, b = bh >> 3, hh = bh & 7;
      const size_t row0 = (size_t)MP + b * 64 + 32 * (wid & 1);
      const int tb = qt * 17, te = tb + 17 > 65 ? 65 : tb + 17;
      attn_unit<96, false, true>(lds, QP + row0 * 768 + hh * 96, 768, KPS + (size_t)bh * TKS * 96, 96, VTS + ((size_t)b * 512 + hh * 64) * TKS, TKS,
                                 tb, te, tb, te - 1, wid < 2, nullptr, 0, 0,
                                 nullptr, 0, nullptr, PART + ((size_t)su * 64 + 32 * (wid & 1)) * 66);
    }
  }
}
DI void mla_combine(const Frame& F) {
  const int tid = otid(), lane = tid & 63;
  const int gw = obid() * 8 + (tid >> 6), nw = ogdim() * 8;
  const float* PART = (const float*)(F.W() + WS_PART); const bf16_t* GA = (const bf16_t*)F.r2(R2_GA); bf16_t* OC = (bf16_t*)(F.W() + WS_OCAT);
  for (int item = gw; item < 64 * 64; item += nw) {
    const int bh = item >> 6, rr = item & 63, b = bh >> 3, hh = bh & 7;
    float m[4], l[4], o[4];
#pragma unroll
    for (int q = 0; q < 4; ++q) { const float* pp = PART + ((size_t)(bh * 4 + q) * 64 + rr) * 66; m[q] = pp[0]; l[q] = pp[1]; o[q] = pp[2 + lane]; }
    const float M = fmaxf(fmaxf(m[0], m[1]), fmaxf(m[2], m[3]));
    float O = 0.f, Lt = 0.f;
#pragma unroll
    for (int q = 0; q < 4; ++q) { const float w = __builtin_amdgcn_exp2f(m[q] - M); O += w * o[q]; Lt += w * l[q]; }
    const size_t row = (size_t)MP + b * 64 + rr;
    const float g = __uint_as_float((unsigned)GA[row * 512 + hh * 64 + lane] << 16);
    OC[row * 1024 + hh * 64 + lane] = (bf16_t)(pk2(O / Lt * g, 0.f) & 0xffffu);
  }
}

struct SchedKV {
  const unsigned char* ws; int layer, G, vcu;
  DI bool next(int i, Unit& u) const {
    int L = i * G + vcu; if (L >= KVT * 4 * DUP_KV) return false;
    L %= KVT * 4;
    const int j = L >> 2, k = L & 3; u.nt = 2;
    const char* CKVB = (const char*)(ws + WS_CKVB); const char* WL = (const char*)(ws + WS_W + (size_t)layer * WL_SIZE);
    if (k < 2) { u.A = CKVB + (size_t)j * 256 * 256; u.B = WL + WL_WUK + (size_t)k * 256 * 256; u.pm = j; u.pn = k; u.kind = 0; }
    else { u.A = WL + WL_WUV + (size_t)(k - 2) * 256 * 256; u.B = CKVB + (size_t)j * 256 * 256; u.pm = k - 2; u.pn = j; u.kind = 1; }
    return true;
  }
};
struct EpiKV {
  const Params* P; int layer;
  DI void operator()(Acc& acc, const Unit& u, int wr, int wc, int fr, int fq) const {
    unsigned char* ws = P->ws; OPAQUE(ws);
    if (u.kind == 0) {
      const float* kn_nope = GP(P->in[17]) + layer * 64; const bf16_t* KRB = (const bf16_t*)(ws + WS_KRB);
      bf16_t* KP = (bf16_t*)(ws + WS_G1 + G1_KP); bf16_t* KPS = (bf16_t*)(ws + WS_G1 + G1_KPS);
      const int head = 4 * u.pn + wc;
      f32x4 gk[2][2];
#pragma unroll
      for (int bj = 0; bj < 2; ++bj) { gk[bj][0] = *(const GAS f32x4*)(kn_nope + 32 * bj + 8 * fq); gk[bj][1] = *(const GAS f32x4*)(kn_nope + 32 * bj + 8 * fq + 4); }
#pragma unroll
      for (int ai = 0; ai < 2; ++ai) {
        u32x4 kr8[8];
#pragma unroll
        for (int k = 0; k < 4; ++k) kr8[ai * 4 + k] = *(const GAS u32x4*)(KRB + (size_t)(u.pm * 256 + 128 * ai + 64 * wr + 16 * k + fr) * 32 + 8 * fq);
#pragma unroll
        for (int m = 0; m < 4; ++m) {
          const int R = u.pm * 256 + 128 * ai + 64 * wr + 16 * m + fr;
          bf16_t* dst;
          if (R < MP) dst = KP + ((size_t)((R >> 13) * 8 + head) * 8192 + (R & 8191)) * 96;
          else { const int Rs = R - MP, b = Rs / TKS, t = Rs - b * TKS; dst = KPS + ((size_t)(b * 8 + head) * TKS + t) * 96; }
          float s = (ss4(acc[ai][0][m][0]) + ss4(acc[ai][0][m][1])) + (ss4(acc[ai][1][m][0]) + ss4(acc[ai][1][m][1]));
          s = red_fq(s);
          const float r2 = __builtin_amdgcn_rsqf(s * (1.0f / 64.0f) + EPSF);
#pragma unroll
          for (int bj = 0; bj < 2; ++bj) {
            const int e0 = 32 * bj + 8 * fq;
            *(GAS u32x4*)(dst + e0) = pack8(acc[ai][bj][m][0] * gk[bj][0] * r2, acc[ai][bj][m][1] * gk[bj][1] * r2);
          }
          *(GAS u32x4*)(dst + 64 + 8 * fq) = kr8[ai * 4 + m];
        }
        FENCE();
      }
    } else {
      bf16_t* VT = (bf16_t*)(ws + WS_G1 + G1_VT); bf16_t* VTS = (bf16_t*)(ws + WS_G1 + G1_VTS);
      const int j = u.pn;
#pragma unroll
      for (int bj = 0; bj < 2; ++bj) {
        const int R = 256 * j + 128 * bj + 32 * wc + 8 * fq;
        bf16_t* base; size_t pitch;
        if (R < MP) { base = VT + (size_t)(R >> 13) * 512 * 8192 + (R & 8191); pitch = 8192; }
        else { const int Rs = R - MP, b = Rs / TKS, t = Rs - b * TKS; base = VTS + (size_t)b * 512 * TKS + t; pitch = TKS; }
#pragma unroll
        for (int ai = 0; ai < 2; ++ai)
#pragma unroll
          for (int m = 0; m < 4; ++m) {
            const int hd = u.pm * 256 + 128 * ai + 64 * wr + 16 * m + fr;
            *(GAS u32x4*)(base + (size_t)hd * pitch) = pack8(acc[ai][bj][m][0], acc[ai][bj][m][1]);
          }
      }
    }
  }
};
template <size_t OFFA, size_t OFFB_L, int LDA, int LDB, int KT, int NTC>
struct SchedRows {
  const unsigned char* ws; int layer, G, vcu;
  DI bool next(int i, Unit& u) const {
    const int L = i * G + vcu; if (L >= MT * NTC) return false;
    u.pm = L / NTC; u.pn = L % NTC; u.kind = 0; u.nt = KT;
    u.A = (const char*)(ws + OFFA) + (size_t)u.pm * 256 * LDA; u.B = (const char*)(ws + WS_W + (size_t)layer * WL_SIZE + OFFB_L) + (size_t)u.pn * 256 * LDB; return true;
  }
};
struct EpiPool {
  const Params* P;
  DI void operator()(Acc& acc, const Unit& u, int wr, int wc, int fr, int fq) const {
    unsigned char* ws = P->ws; OPAQUE(ws);
    const bf16_t* GB = (const bf16_t*)(ws + WS_GB); bf16_t* OC = (bf16_t*)(ws + WS_OCAT);
#pragma unroll
    for (int ai = 0; ai < 2; ++ai) {
      u32x4 g16[4][2];
#pragma unroll
      for (int m = 0; m < 4; ++m)
#pragma unroll
        for (int bj = 0; bj < 2; ++bj) g16[m][bj] = *(const GAS u32x4*)(GB + (size_t)(u.pm * 256 + 128 * ai + 64 * wr + 16 * m + fr) * 256 + 128 * bj + 32 * wc + 8 * fq);
#pragma unroll
      for (int m = 0; m < 4; ++m) {
        const int row = u.pm * 256 + 128 * ai + 64 * wr + 16 * m + fr;
#pragma unroll
        for (int bj = 0; bj < 2; ++bj) {
          const int c0 = 128 * bj + 32 * wc + 8 * fq;
          const u32x4 g = g16[m][bj];
          f32x4 a = acc[ai][bj][m][0], b = acc[ai][bj][m][1];
          a[0] *= bflo(g.x); a[1] *= bfhi(g.x); a[2] *= bflo(g.y); a[3] *= bfhi(g.y);
          b[0] *= bflo(g.z); b[1] *= bfhi(g.z); b[2] *= bflo(g.w); b[3] *= bfhi(g.w);
          *(GAS u32x4*)(OC + (size_t)row * 1024 + 512 + c0) = pack8(a, b);
        }
      }
      FENCE();
    }
  }
};

struct SchedMerge {
  const unsigned char* ws; int layer, G, vcu;
  DI bool next(int i, Unit& u) const {
    const int nfull = vcu < 1024 ? (1024 - vcu + G - 1) / G : 0;
    int ti, sub;
    if (i < 6 * nfull) { ti = i / 6; sub = i - ti * 6; }
    else { const int j = i - 6 * nfull, tj = j / 3; ti = nfull + tj; sub = 2 * (j - tj * 3) + 1; }
    const int L = ti * G + vcu; if (L >= MT * 4) return false;
    const int pm = L >> 2, pn = L & 3, s = sub >> 1;
    u.pm = pm; u.pn = pn; u.kind = sub;
    const char* WL = (const char*)(ws + WS_W + (size_t)layer * WL_SIZE);
    if ((sub & 1) == 0) { u.A = (const char*)(ws + WS_XB) + (size_t)pm * 256 * 2048; u.B = WL + WL_WIN + (size_t)(2560 + s * 1024 + pn * 256) * 2048; u.nt = 16; }
    else { const int koff = s == 0 ? 0 : (s == 1 ? 512 : 768); u.A = (const char*)(ws + WS_OCAT) + (size_t)pm * 256 * 2048 + koff * 2; u.B = WL + WL_WCAT + (size_t)pn * 256 * 2048 + koff * 2; u.nt = s == 0 ? 8 : 4; }
    return true;
  }
};
struct EpiMerge {
  const Params* P;
  DI void operator()(Acc& acc, const Unit& u, int wr, int wc, int fr, int fq) const {
    const int tid = otid();
    unsigned char* ws = P->ws; OPAQUE(ws);
    GAS u32x4* gs = (GAS u32x4*)(ws + WS_R2 + (size_t)obid() * P6_SCR_PER_WG); GAS u32x4* ms = gs + 16 * 512;
    if ((u.kind & 1) == 0) {
      const float* SSQX = (const float*)(ws + WS_SSQX);
      float rs8[8];
      rstd8(SSQX, u.pm * 256 + 64 * wr + fr, fq, 1.0f / 1024.0f, rs8);
#pragma unroll
      for (int ai = 0; ai < 2; ++ai)
#pragma unroll
        for (int m = 0; m < 4; ++m) {
          const float rs = rs8[ai * 4 + m];
#pragma unroll
          for (int bj = 0; bj < 2; ++bj) {
            f32x4 a = acc[ai][bj][m][0] * rs, b = acc[ai][bj][m][1] * rs;
#pragma unroll
            for (int q = 0; q < 4; ++q) { a[q] = sigmoidf_(a[q]); b[q] = sigmoidf_(b[q]); }
            gs[((ai * 2 + bj) * 4 + m) * 512 + tid] = pack8(a, b);
          }
          FENCE();
        }
    } else {
      const int s = u.kind >> 1;
      bf16_t* MB = (bf16_t*)(ws + WS_G1 + G1_MB);
#pragma unroll
      for (int ai = 0; ai < 2; ++ai) {
        u32x4 g[2][4], mo[2][4];
#pragma unroll
        for (int bj = 0; bj < 2; ++bj)
#pragma unroll
          for (int m = 0; m < 4; ++m) {
            if (u.pm < 256) g[bj][m] = gs[((ai * 2 + bj) * 4 + m) * 512 + tid];
            else g[bj][m] = *(const GAS u32x4*)((const bf16_t*)(ws + WS_GMS) + (size_t)((u.pm - 256) * 256 + 128 * ai + 64 * wr + 16 * m + fr) * 3072 + s * 1024 + u.pn * 256 + 128 * bj + 32 * wc + 8 * fq);
            if (s > 0) mo[bj][m] = ms[((ai * 2 + bj) * 4 + m) * 512 + tid]; }
#pragma unroll
        for (int m = 0; m < 4; ++m) {
          const int row = u.pm * 256 + 128 * ai + 64 * wr + 16 * m + fr;
#pragma unroll
          for (int bj = 0; bj < 2; ++bj) {
            const int idx = (ai * 2 + bj) * 4 + m;
            const u32x4 gg = g[bj][m];
            f32x4 a = acc[ai][bj][m][0], b = acc[ai][bj][m][1];
            a[0] *= bflo(gg.x); a[1] *= bfhi(gg.x); a[2] *= bflo(gg.y); a[3] *= bfhi(gg.y);
            b[0] *= bflo(gg.z); b[1] *= bfhi(gg.z); b[2] *= bflo(gg.w); b[3] *= bfhi(gg.w);
            if (s > 0) { const u32x4 mm = mo[bj][m];
              a[0] += bflo(mm.x); a[1] += bfhi(mm.x); a[2] += bflo(mm.y); a[3] += bfhi(mm.y);
              b[0] += bflo(mm.z); b[1] += bfhi(mm.z); b[2] += bflo(mm.w); b[3] += bfhi(mm.w); }
            if (s < 2) ms[idx * 512 + tid] = pack8(a, b);
            else *(GAS u32x4*)(MB + (size_t)row * 1024 + u.pn * 256 + 128 * bj + 32 * wc + 8 * fq) = pack8(a, b);
          }
        }
        FENCE();
      }
    }
  }
};

struct EpiProj {
  const Params* P;
  DI void operator()(Acc& acc, const Unit& u, int wr, int wc, int fr, int fq) const {
    unsigned char* ws = P->ws; OPAQUE(ws);
    bf16_t* PROJ = (bf16_t*)(ws + WS_R2);
#pragma unroll
    for (int ai = 0; ai < 2; ++ai)
#pragma unroll
      for (int m = 0; m < 4; ++m) {
        const int row = u.pm * 256 + 128 * ai + 64 * wr + 16 * m + fr;
#pragma unroll
        for (int bj = 0; bj < 2; ++bj) *(GAS u32x4*)(PROJ + (size_t)row * 1024 + u.pn * 256 + 128 * bj + 32 * wc + 8 * fq) = pack8(acc[ai][bj][m][0], acc[ai][bj][m][1]);
      }
  }
};
struct EpiOut {
  const Params* P; long long dp, ds;
  DI void operator()(Acc& acc, const Unit& u, int wr, int wc, int fr, int fq) const {
    unsigned char* ws = P->ws; float* Y = P->out; OPAQUE(ws); OPAQUE(Y);
    bf16_t* X1B = (bf16_t*)(ws + WS_OCAT); float* SSQ1 = (float*)(ws + WS_SSQ1);
    const int cb = u.pn * 256 + 32 * wc + 8 * fq;
    long long dsel = u.pm < 256 ? dp : ds; asm volatile("" : "+s"(dsel));
    const float* Xs = (const float*)((const char*)Y + dsel);
#pragma unroll
    for (int ai = 0; ai < 2; ++ai)
#pragma unroll
      for (int mp = 0; mp < 2; ++mp) {
        f32x4 xin[2][2][2];
#pragma unroll
        for (int mm = 0; mm < 2; ++mm)
#pragma unroll
          for (int bj = 0; bj < 2; ++bj) {
            const float* xr = Xs + (size_t)(u.pm * 256 + 128 * ai + 64 * wr + 16 * (2 * mp + mm) + fr) * 1024 + cb + 128 * bj;
            xin[mm][bj][0] = *(const GAS f32x4*)(xr); xin[mm][bj][1] = *(const GAS f32x4*)(xr + 4);
          }
#pragma unroll
        for (int mm = 0; mm < 2; ++mm) {
          const int m = 2 * mp + mm;
          const int row = u.pm * 256 + 128 * ai + 64 * wr + 16 * m + fr;
          float s = 0.f;
#pragma unroll
          for (int bj = 0; bj < 2; ++bj) {
            const int c0 = cb + 128 * bj;
            const f32x4 a = xin[mm][bj][0] + acc[ai][bj][m][0], b = xin[mm][bj][1] + acc[ai][bj][m][1];
            s += ss4(a) + ss4(b);
            *(GAS f32x4*)(Y + (size_t)row * 1024 + c0) = a; *(GAS f32x4*)(Y + (size_t)row * 1024 + c0 + 4) = b;
            *(GAS u32x4*)(X1B + (size_t)row * 1024 + c0) = pack8(a, b);
          }
          s = red_fq(s);
          if (fq == 0) *(GAS float*)(SSQ1 + (size_t)row * 16 + u.pn * 4 + wc) = s;
        }
        FENCE();
      }
  }
};
struct EpiPle {
  const Params* P; int write_next_;
  DI void operator()(Acc& acc, const Unit& u, int wr, int wc, int fr, int fq) const {
    if (write_next_) body<true>(acc, u, wr, wc, fr, fq); else body<false>(acc, u, wr, wc, fr, fq);
  }
  template <bool write_next>
  DI void body(Acc& acc, const Unit& u, int wr, int wc, int fr, int fq) const {
    unsigned char* ws = P->ws; float* Y = P->out; OPAQUE(ws); OPAQUE(Y);
    const float* SSQ1 = (const float*)(ws + WS_SSQ1); const bf16_t* PROJ = (const bf16_t*)(ws + WS_R2);
    bf16_t* XB = (bf16_t*)(ws + WS_XB); float* SSQX = (float*)(ws + WS_SSQX);
    float rs8[8];
    rstd8(SSQ1, u.pm * 256 + 64 * wr + fr, fq, 1.0f / 1024.0f, rs8);
    const int cb = u.pn * 256 + 32 * wc + 8 * fq;
#pragma unroll
    for (int ai = 0; ai < 2; ++ai)
#pragma unroll
      for (int mp = 0; mp < 2; ++mp) {
        f32x4 xin[2][2][2]; u32x4 pj[2][2];
#pragma unroll
        for (int mm = 0; mm < 2; ++mm)
#pragma unroll
          for (int bj = 0; bj < 2; ++bj) {
            const size_t off = (size_t)(u.pm * 256 + 128 * ai + 64 * wr + 16 * (2 * mp + mm) + fr) * 1024 + cb + 128 * bj;
            xin[mm][bj][0] = *(const GAS f32x4*)(Y + off); xin[mm][bj][1] = *(const GAS f32x4*)(Y + off + 4); pj[mm][bj] = *(const GAS u32x4*)(PROJ + off);
          }
#pragma unroll
        for (int mm = 0; mm < 2; ++mm) {
          const int m = 2 * mp + mm;
          const int row = u.pm * 256 + 128 * ai + 64 * wr + 16 * m + fr;
          const float rs = rs8[ai * 4 + m];
          float s = 0.f;
#pragma unroll
          for (int bj = 0; bj < 2; ++bj) {
            const int c0 = cb + 128 * bj;
            const u32x4 pq = pj[mm][bj];
            f32x4 a = acc[ai][bj][m][0] * rs, b = acc[ai][bj][m][1] * rs;
            const f32x4 xa = xin[mm][bj][0], xb = xin[mm][bj][1];
            a[0] = xa[0] + sigmoidf_(a[0]) * bflo(pq.x); a[1] = xa[1] + sigmoidf_(a[1]) * bfhi(pq.x); a[2] = xa[2] + sigmoidf_(a[2]) * bflo(pq.y); a[3] = xa[3] + sigmoidf_(a[3]) * bfhi(pq.y);
            b[0] = xb[0] + sigmoidf_(b[0]) * bflo(pq.z); b[1] = xb[1] + sigmoidf_(b[1]) * bfhi(pq.z); b[2] = xb[2] + sigmoidf_(b[2]) * bflo(pq.w); b[3] = xb[3] + sigmoidf_(b[3]) * bfhi(pq.w);
            *(GAS f32x4*)(Y + (size_t)row * 1024 + c0) = a; *(GAS f32x4*)(Y + (size_t)row * 1024 + c0 + 4) = b;
            if (write_next) { s += ss4(a) + ss4(b); *(GAS u32x4*)(XB + (size_t)row * 1024 + c0) = pack8(a, b); }
          }
          if (write_next) { s = red_fq(s); if (fq == 0) *(GAS float*)(SSQX + (size_t)row * 16 + u.pn * 4 + wc) = s; }
        }
        FENCE();
      }
  }
};

#define XB_TMO      128
#define XB_XCNT(j)  (256  + 64 * (j))
#define XB_XSUB(j)  (1280 + 64 * (j))
#define XB_XGEN(j)  (2304 + 64 * (j))
#define XB_TOP      3328
#define XB_TOPGEN   3392
#define XCD_BAR_WORDS 3456
#define XB_SPIN_CAP (1u << 18)
DI unsigned xb_ld(unsigned* p)              { return __hip_atomic_load(p, __ATOMIC_RELAXED, __HIP_MEMORY_SCOPE_AGENT); }
DI unsigned xb_add(unsigned* p, unsigned v) { return __hip_atomic_fetch_add(p, v, __ATOMIC_RELAXED, __HIP_MEMORY_SCOPE_AGENT); }
DI unsigned xb_xcc_id() { return (unsigned)__builtin_amdgcn_s_getreg((3 << 11) | 20) & 0xFu; }
#define XB_SPIN(cond, bar) do { unsigned _sp = 0; while (cond) { __builtin_amdgcn_s_sleep(1); \
    if ((++_sp & 255u) == 0u) { if (xb_ld(&(bar)[XB_TMO])) break; if (_sp > XB_SPIN_CAP) { atomicAdd(&(bar)[XB_TMO], 1u); break; } } } } while (0)
struct XcdBarrier { unsigned* bar; unsigned x; volatile LAS unsigned* st; };
DI XcdBarrier xcd_barrier_post(unsigned* bar, volatile LAS unsigned* st) {
  XcdBarrier b; b.bar = bar; b.x = xb_xcc_id(); b.st = st;
  if (threadIdx.x == 0) (void)xb_add(&bar[XB_XCNT(b.x)], 1u);
  return b;
}
DI void xcd_barrier_complete(unsigned* bar, unsigned x, unsigned& nloc, unsigned& nx) {
  const unsigned G = gridDim.x * gridDim.y * gridDim.z;
  unsigned sum, cnt, mine, sp = 0u;
  for (;;) {
    sum = 0u; cnt = 0u; mine = 0u;
#pragma unroll
    for (unsigned j = 0; j < 16; ++j) { const unsigned c = xb_ld(&bar[XB_XCNT(j)]); sum += c; cnt += (c > 0u) ? 1u : 0u; mine = (j == x) ? c : mine; }
    if (sum == G) break;
    __builtin_amdgcn_s_sleep(1);
    if ((++sp & 255u) == 0u) { if (xb_ld(&bar[XB_TMO])) break; if (sp > XB_SPIN_CAP) { atomicAdd(&bar[XB_TMO], 1u); break; } }
  }
  nloc = mine > 0u ? mine : 1u; nx = cnt > 0u ? cnt : 1u;
}
DI void xcd_barrier(const XcdBarrier& b) {
  asm volatile("s_waitcnt vmcnt(0)" ::: "memory");
  __syncthreads();
  if (threadIdx.x == 0) {
    unsigned* bar = b.bar;
    __builtin_amdgcn_s_waitcnt(0);
    unsigned nloc = b.st[0], nx = b.st[1];
    if (nloc == 0u) { xcd_barrier_complete(bar, b.x, nloc, nx); b.st[0] = nloc; b.st[1] = nx; }
    const unsigned old = xb_add(&bar[XB_XSUB(b.x)], 1u);
    const unsigned gen = old / nloc;
    if (old + 1u == (gen + 1u) * nloc) {
      __builtin_amdgcn_fence(__ATOMIC_RELEASE, "agent");
      asm volatile("s_waitcnt vmcnt(0)" ::: "memory");
      const unsigned og = xb_add(&bar[XB_TOP], 1u);
      const unsigned tg = og / nx;
      if (og + 1u == (tg + 1u) * nx) xb_add(&bar[XB_TOPGEN], 1u);
      else XB_SPIN(xb_ld(&bar[XB_TOPGEN]) == tg, bar);
      __builtin_amdgcn_fence(__ATOMIC_ACQUIRE, "agent");
      xb_add(&bar[XB_XGEN(b.x)], 1u);
      asm volatile("s_waitcnt vmcnt(0)" ::: "memory");
    } else {
      XB_SPIN(xb_ld(&bar[XB_XGEN(b.x)]) == gen, bar);
      __builtin_amdgcn_fence(__ATOMIC_ACQUIRE, "agent");
      asm volatile("s_waitcnt vmcnt(0)" ::: "memory");
    }
  }
  __syncthreads();
}

__global__ void __launch_bounds__(512) fwd_megakernel(Params p) {
  extern __shared__ __attribute__((aligned(16))) unsigned char lds_raw[];
  LAS unsigned char* lds = (LAS unsigned char*)lds_raw;
  cg::grid_group grid = cg::this_grid();
  Frame F;
  F.P = &p;
  F.out = p.out; F.ws = p.ws; F.G = gridDim.x; F.layer = 0;
  { const int bx = blockIdx.x; F.vcu = (F.G % 8 == 0) ? (bx % 8) * (F.G / 8) + bx / 8 : bx; }

  volatile LAS unsigned* xst = (volatile LAS unsigned*)(lds + LDS_BYTES - 16);
  if (threadIdx.x == 0) { xst[0] = 0u; xst[1] = 0u; }
  __syncthreads();
  (void)xcd_barrier_post((unsigned*)(p.ws + WS_BAR), xst);
#define XBAR() do { XcdBarrier b_; b_.bar = (unsigned*)(F.W() + WS_BAR); b_.x = xb_xcc_id(); b_.st = (volatile LAS unsigned*)(lds + LDS_BYTES - 16); xcd_barrier(b_); } while (0)
  REPLOOP(REP_P0) { prep_weights(F, lds); prep_misc(F); }
  grid.sync();

#pragma unroll 1
  for (int layer = 0; layer < 2; ++layer) {
    F.layer = layer;
#define REFRESH() asm volatile("" : "+s"(F.vcu), "+s"(F.G), "+s"(F.ws), "+s"(F.out))
    REFRESH();
    if (STAGE_LIMIT >= 2) REPLOOP(REP_P2) {
      SchedZ S{F.W(), layer, F.G, F.vcu};
      EpiZ E{&p, layer};
      pg8::gemm_phase(lds, 2048, 2048, S, E);
    }
    XBAR();
    REFRESH();
    if (STAGE_LIMIT >= 3) REPLOOP(REP_P3) {
      SchedQ S{F.W(), layer, F.G, F.vcu};
      EpiQ E{&p, layer};
      pg8::gemm_phase(lds, 512, 512, S, E);
      post_kv(F);
      pooled_rows(F);
      conv_layer(F);
      __syncthreads();
      if (STAGE_LIMIT >= 4) ca_phase(F, lds);
    }
    XBAR();
    REFRESH();
    if (STAGE_LIMIT >= 5) REPLOOP(REP_P4) {
      SchedKV S{F.W(), layer, F.G, F.vcu};
      EpiKV E{&p, layer};
      pg8::gemm_phase(lds, 256, 256, S, E);
      SchedRows<WS_POOLED, WL_WPOOL, 512, 512, 4, 1> S2{F.W(), layer, F.G, F.vcu};
      EpiPool E2{&p};
      pg8::gemm_phase(lds, 512, 512, S2, E2);
    }
    XBAR();
    REFRESH();
    if (STAGE_LIMIT >= 6) REPLOOP(REP_P5) mla_phase(F, lds);
    XBAR();
    REFRESH();
    if (STAGE_LIMIT >= 6) mla_combine(F);
    XBAR();
    REFRESH();
    if (STAGE_LIMIT >= 7) REPLOOP(REP_P6) {
      SchedMerge S{F.W(), layer, F.G, F.vcu};
      EpiMerge E{&p};
      pg8::gemm_phase(lds, 2048, 2048, S, E);
    }
    XBAR();
    REFRESH();
    if (STAGE_LIMIT >= 8) {
      SchedRows<WS_PB, WL_WPROJ, 512, 512, 4, 4> S1{F.W(), layer, F.G, F.vcu};
      EpiProj E1{&p};
      pg8::gemm_phase(lds, 512, 512, S1, E1);
      SchedRows<WS_G1 + G1_MB, WL_WOUT, 2048, 2048, 16, 4> S2{F.W(), layer, F.G, F.vcu};
      EpiOut E2{&p, layer == 0 ? (long long)((const char*)p.in[0] - (const char*)p.out) : 0ll, layer == 0 ? (long long)((const char*)p.in[1] - (const char*)p.out) - (long long)MP * 4096 : 0ll};
      stagger_odd(F.vcu, 4);
      pg8::gemm_phase(lds, 2048, 2048, S2, E2);
    }
    XBAR();
    REFRESH();
    if (STAGE_LIMIT >= 9) {
      SchedRows<WS_OCAT, WL_WPG, 2048, 2048, 16, 4> S{F.W(), layer, F.G, F.vcu};
      EpiPle E{&p, layer == 0 ? 1 : 0};
      stagger_odd(F.vcu, 4);
      pg8::gemm_phase(lds, 2048, 2048, S, E);
    }
    if (layer == 0) XBAR();
  }
}

extern "C" void kernel_launch(void* const* d_in, const int* in_sizes, int n_in, void* d_out, int out_size, void* d_ws, size_t ws_size, hipStream_t stream) {
  static int grid_blocks = 0;
  if (grid_blocks == 0) {
    if (n_in != 31 || (size_t)out_size != O_END || ws_size < WS_END) {
      fprintf(stderr, "kernel_launch: unexpected shapes n_in=%d out=%d (want %zu) ws=%zu (need %zu)\n", n_in, out_size, (size_t)O_END, ws_size, (size_t)WS_END);
      grid_blocks = -1; return;
    }
    int dev = 0, cus = 0, per_cu = 0;
    hipGetDevice(&dev);
    hipDeviceGetAttribute(&cus, hipDeviceAttributeMultiprocessorCount, dev);
    hipFuncSetAttribute((const void*)fwd_megakernel, hipFuncAttributeMaxDynamicSharedMemorySize, LDS_BYTES);
    hipOccupancyMaxActiveBlocksPerMultiprocessor(&per_cu, (const void*)fwd_megakernel, 512, LDS_BYTES);
    if (per_cu < 1) { fprintf(stderr, "kernel_launch: occupancy query says %d blocks/CU\n", per_cu); per_cu = 1; }
    grid_blocks = cus;
    if (grid_blocks > 256) grid_blocks = 256;
  }
  if (grid_blocks < 0) return;
  (void)hipMemsetAsync((unsigned char*)d_ws + WS_BAR, 0, XCD_BAR_WORDS * 4, stream);
  Params p{};
  for (int i = 0; i < 31; ++i) p.in[i] = (const float*)d_in[i];
  p.out = (float*)d_out; p.ws = (unsigned char*)d_ws; p.G = grid_blocks; p.pad = 0;
  void* args[] = {&p};
  hipError_t e = hipLaunchCooperativeKernel((const void*)fwd_megakernel, dim3(grid_blocks), dim3(512), args, LDS_BYTES, stream);
  if (e != hipSuccess) fprintf(stderr, "cooperative launch failed: %s (grid %d)\n", hipGetErrorString(e), grid_blocks);
}
```
